# Optimizing an MI355X kernel written in HIP

```python
import math
import jax, jax.numpy as jnp
from jax import lax
import numpy as np

D_MODEL = 1024
BATCH = 4
SEQ = 8192
DEPTH = 1

N_MEM = 256
D_RNN = D_MODEL
N_LRU_HEADS = 8
LRU_BLOCK = D_RNN // N_LRU_HEADS
LRU_CONV = 4
LRU_C = 8.0
D_CONV = D_MODEL
SC_CONV = 3
N_XHEADS = 4
XHEAD_DIM = D_MODEL // N_XHEADS
D_FF = 3 * D_MODEL
FFN_CONV = 3
LN_EPS = 1e-5
DN_ALPHA = (2.0 * DEPTH) ** 0.25
DN_BETA = (8.0 * DEPTH) ** -0.25
IN_SPLITS = [D_RNN, D_RNN, D_CONV, D_CONV, D_CONV, D_MODEL, D_MODEL]
IN_COLS = sum(IN_SPLITS)

kernel_name = "hawk_shortconv_gated_hybrid_deepnorm"


def layer_norm(x, g, b):
    xf = x.astype(jnp.float32)
    mu = jnp.mean(xf, axis=-1, keepdims=True)
    var = jnp.mean(jnp.square(xf - mu), axis=-1, keepdims=True)
    y = (xf - mu) * lax.rsqrt(var + LN_EPS)
    return (y * g.astype(jnp.float32) + b.astype(jnp.float32)).astype(x.dtype)


def causal_dwconv(u, w):
    k_width = w.shape[0]
    s = u.shape[1]
    up = jnp.pad(u, ((0, 0), (k_width - 1, 0), (0, 0)))
    return sum(up[:, k_width - 1 - k: k_width - 1 - k + s] * w[k] for k in range(k_width))


def block_diag_linear(u, w, b):
    bsz, s, d = u.shape
    uh = u.reshape(bsz, s, w.shape[0], w.shape[1])
    return jnp.einsum('bshi,hij->bshj', uh, w).reshape(bsz, s, d) + b


def rg_lru(u, w_r, b_r, w_i, b_i, lam):
    s = u.shape[1]
    r = jax.nn.sigmoid(block_diag_linear(u, w_r, b_r).astype(jnp.float32))
    i = jax.nn.sigmoid(block_diag_linear(u, w_i, b_i).astype(jnp.float32))
    log_a = -LRU_C * r * jax.nn.softplus(-lam.astype(jnp.float32))
    a = jnp.exp(log_a)
    mult = jnp.sqrt(-jnp.expm1(2.0 * log_a))
    is_first = (jnp.arange(s) == 0)[None, :, None]
    mult = jnp.where(is_first, 1.0, mult)
    bterm = mult * (i * u.astype(jnp.float32))

    def combine(left, right):
        a_l, b_l = left
        a_r, b_r_ = right
        return a_l * a_r, a_r * b_l + b_r_

    _, h = lax.associative_scan(combine, (a, bterm), axis=1)
    return h.astype(u.dtype)


def setup_inputs(seed: int = 0) -> dict:
    key = jax.random.key(seed)
    ks = iter(jax.random.split(key, 40))

    def nrm(shape, scale):
        return jax.random.normal(next(ks), shape, jnp.float32) * scale

    def gain(shape):
        return 1.0 + nrm(shape, 0.02)

    L = DEPTH
    x = nrm((BATCH, SEQ, D_MODEL), 1.0)
    mem = nrm((BATCH, N_MEM, D_MODEL), 1.0)
    a_c = jax.random.uniform(next(ks), (L, D_RNN), jnp.float32, 0.9, 0.999)
    p = a_c ** (1.0 / LRU_C)
    lru_lambda = jnp.log(p) - jnp.log1p(-p)
    return {
        "x": x,
        "mem": mem,
        "w_in": nrm((L, D_MODEL, IN_COLS), D_MODEL ** -0.5),
        "lru_conv_w": nrm((L, LRU_CONV, D_RNN), LRU_CONV ** -0.5),
        "lru_conv_b": nrm((L, D_RNN), 0.02),
        "w_rgate": nrm((L, N_LRU_HEADS, LRU_BLOCK, LRU_BLOCK), LRU_BLOCK ** -0.5),
        "b_rgate": nrm((L, D_RNN), 0.02),
        "w_igate": nrm((L, N_LRU_HEADS, LRU_BLOCK, LRU_BLOCK), LRU_BLOCK ** -0.5),
        "b_igate": nrm((L, D_RNN), 0.02),
        "lru_lambda": lru_lambda,
        "w_lru_out": nrm((L, D_RNN, D_MODEL), DN_BETA * D_RNN ** -0.5),
        "sc_conv_w": nrm((L, SC_CONV, D_CONV), SC_CONV ** -0.5),
        "w_sc_out": nrm((L, D_CONV, D_MODEL), DN_BETA * D_CONV ** -0.5),
        "b_merge": nrm((L, 2, D_MODEL), 0.02),
        "w_mix_out": nrm((L, D_MODEL, D_MODEL), DN_BETA * D_MODEL ** -0.5),
        "ln1_g": gain((L, D_MODEL)),
        "ln1_b": nrm((L, D_MODEL), 0.02),
        "w_q": nrm((L, D_MODEL, D_MODEL), D_MODEL ** -0.5),
        "w_k": nrm((L, D_MODEL, D_MODEL), D_MODEL ** -0.5),
        "w_v": nrm((L, D_MODEL, D_MODEL), DN_BETA * D_MODEL ** -0.5),
        "w_xo": nrm((L, D_MODEL, D_MODEL), DN_BETA * D_MODEL ** -0.5),
        "ln2_g": gain((L, D_MODEL)),
        "ln2_b": nrm((L, D_MODEL), 0.02),
        "w_ffn_gate": nrm((L, D_MODEL, D_FF), D_MODEL ** -0.5),
        "w_ffn_up": nrm((L, D_MODEL, D_FF), DN_BETA * D_MODEL ** -0.5),
        "ffn_conv_w": nrm((L, FFN_CONV, D_FF), FFN_CONV ** -0.5),
        "ffn_conv_b": nrm((L, D_FF), 0.02),
        "w_ffn_down": nrm((L, D_FF, D_MODEL), DN_BETA * D_FF ** -0.5),
        "ln3_g": gain((L, D_MODEL)),
        "ln3_b": nrm((L, D_MODEL), 0.02),
    }


def reference(x, mem, w_in, lru_conv_w, lru_conv_b, w_rgate, b_rgate, w_igate, b_igate,
              lru_lambda, w_lru_out, sc_conv_w, w_sc_out, b_merge, w_mix_out, ln1_g, ln1_b,
              w_q, w_k, w_v, w_xo, ln2_g, ln2_b, w_ffn_gate, w_ffn_up, ffn_conv_w, ffn_conv_b,
              w_ffn_down, ln3_g, ln3_b):
    bsz, s, _ = x.shape
    n_mem = mem.shape[1]
    split_idx = list(np.cumsum(IN_SPLITS)[:-1])
    for l in range(DEPTH):
        proj = x @ w_in[l]
        lru_gate, lru_in, sc_b, sc_c, sc_h, g_lru, g_sc = jnp.split(proj, split_idx, axis=-1)
        u = causal_dwconv(lru_in, lru_conv_w[l]) + lru_conv_b[l]
        h = rg_lru(u, w_rgate[l], b_rgate[l], w_igate[l], b_igate[l], lru_lambda[l])
        y_lru = (jax.nn.gelu(lru_gate) * h) @ w_lru_out[l]
        y_sc = (sc_b * causal_dwconv(sc_c * sc_h, sc_conv_w[l])) @ w_sc_out[l]
        merged = (jax.nn.sigmoid(g_lru + b_merge[l, 0]) * y_lru
                  + jax.nn.sigmoid(g_sc + b_merge[l, 1]) * y_sc)
        x = layer_norm(DN_ALPHA * x + merged @ w_mix_out[l], ln1_g[l], ln1_b[l])

        q = (x @ w_q[l]).reshape(bsz, s, N_XHEADS, XHEAD_DIM)
        k = (mem @ w_k[l]).reshape(bsz, n_mem, N_XHEADS, XHEAD_DIM)
        v = (mem @ w_v[l]).reshape(bsz, n_mem, N_XHEADS, XHEAD_DIM)
        scores = jnp.einsum('bshd,bmhd->bhsm', q, k).astype(jnp.float32) * (XHEAD_DIM ** -0.5)
        probs = jax.nn.softmax(scores, axis=-1).astype(v.dtype)
        att = jnp.einsum('bhsm,bmhd->bshd', probs, v).reshape(bsz, s, D_MODEL)
        x = layer_norm(DN_ALPHA * x + att @ w_xo[l], ln2_g[l], ln2_b[l])

        gate = causal_dwconv(x @ w_ffn_gate[l], ffn_conv_w[l]) + ffn_conv_b[l]
        ffn = (jax.nn.gelu(gate) * (x @ w_ffn_up[l])) @ w_ffn_down[l]
        x = layer_norm(DN_ALPHA * x + ffn, ln3_g[l], ln3_b[l])
    return x
```

```cpp
#include <hip/hip_runtime.h>
#include <hip/hip_cooperative_groups.h>
#include <cstdio>
namespace cg = cooperative_groups;

#define LAS __attribute__((address_space(3)))
typedef unsigned short bf16_t;
typedef short bf16x8 __attribute__((ext_vector_type(8)));
typedef float f32x4 __attribute__((ext_vector_type(4)));
typedef float f32x2 __attribute__((ext_vector_type(2)));
typedef unsigned u32x4 __attribute__((ext_vector_type(4)));
typedef unsigned u32x2 __attribute__((ext_vector_type(2)));
typedef _Float16 h16x2 __attribute__((ext_vector_type(2)));

constexpr int MT = 32768, DM = 1024, SEQ = 8192, NMEM = 256, DFF = 3072;
constexpr float ALPHA = 1.189207115002721f, LN_EPS = 1e-5f;
constexpr size_t MiB = (size_t)1 << 20;
constexpr size_t WS_WIN = 0, WS_WG = 14 * MiB, WS_WLRU = 15 * MiB, WS_WSC = 17 * MiB, WS_WMIX = 19 * MiB, WS_WQ = 21 * MiB, WS_WK = 23 * MiB, WS_WV = 25 * MiB,
                 WS_WXO = 27 * MiB, WS_WFG = 29 * MiB, WS_WFU = 35 * MiB, WS_WFD = 41 * MiB, WS_MEMB = 47 * MiB, WS_KB = 49 * MiB, WS_VT = 51 * MiB, WS_RS = 53 * MiB,
                 WS_AGG = 55 * MiB, WS_SP = 57 * MiB, WS_SLOT = 58 * MiB, SLOT = 64 * MiB, WS_END = WS_SLOT + 7 * SLOT;
constexpr int LDS_STAGE = 131072, LDS_XB = LDS_STAGE + 4096, LDS_BYTES = LDS_STAGE + 8192;
constexpr size_t WS_BAR = WS_SP + 65536;

__device__ __forceinline__ unsigned cvt_pk_bf16(float lo, float hi) { unsigned r; asm volatile("v_cvt_pk_bf16_f32 %0, %1, %2" : "=v"(r) : "v"(lo), "v"(hi)); return r; }
__device__ __forceinline__ float bf_lo(unsigned w) { return __uint_as_float(w << 16); }
__device__ __forceinline__ float bf_hi(unsigned w) { return __uint_as_float(w & 0xffff0000u); }
__device__ __forceinline__ void unpack8(const u32x4 w, float (&f)[8]) { f[0] = bf_lo(w.x); f[1] = bf_hi(w.x); f[2] = bf_lo(w.y); f[3] = bf_hi(w.y); f[4] = bf_lo(w.z); f[5] = bf_hi(w.z); f[6] = bf_lo(w.w); f[7] = bf_hi(w.w); }
__device__ __forceinline__ u32x4 pack8(const float (&f)[8]) { u32x4 w; w.x = cvt_pk_bf16(f[0], f[1]); w.y = cvt_pk_bf16(f[2], f[3]); w.z = cvt_pk_bf16(f[4], f[5]); w.w = cvt_pk_bf16(f[6], f[7]); return w; }
__device__ __forceinline__ float sigmoidf_(float x) { return __builtin_amdgcn_rcpf(1.0f + __builtin_amdgcn_exp2f(-1.4426950408889634f * x)); }
__device__ __forceinline__ float gelu_tanh(float x) { const float z = 1.5957691216057308f * (x + 0.044715f * x * x * x); return x * sigmoidf_(z); }
__device__ __forceinline__ unsigned pack_h2(float a, float b) { h16x2 h; h.x = (_Float16)a; h.y = (_Float16)b; return __builtin_bit_cast(unsigned, h); }
__device__ __forceinline__ f32x2 unpack_h2(unsigned w) { const h16x2 h = __builtin_bit_cast(h16x2, w); return (f32x2){(float)h.x, (float)h.y}; }

__device__ __forceinline__ int tid_opaque() { int t = threadIdx.x; asm volatile("" : "+v"(t)); return t; }

__device__ __forceinline__ int vblk() { const int b = blockIdx.x; return (gridDim.x == 256) ? ((b & 7) * 32 + (b >> 3)) : b; }
__device__ __forceinline__ float bperm_xor(float x, int lane_op, int mask) { return __int_as_float(__builtin_amdgcn_ds_bpermute((lane_op ^ mask) << 2, __float_as_int(x))); }

constexpr int BM = 256, BK = 64, HALF = 128, HTB = HALF * BK * 2;
__device__ __forceinline__ int lds_byte(int r, int c) { const int st = (r >> 4) * 2 + (c >> 5), rr = r & 15, cc = c & 31, ob = rr * 64 + cc * 2; return st * 1024 + (ob ^ (((ob >> 9) & 1) << 5)); }
__device__ __forceinline__ void stage_rc(int b, int& R, int& C) { const int st = b / 1024, sb = b % 1024, swz = sb ^ (((sb >> 9) & 1) << 5); R = (st >> 1) * 16 + swz / 64; C = (st & 1) * 32 + (swz % 64) / 2; }
__device__ __forceinline__ int perm32(int rho) { const int n = rho >> 4, i = rho & 15; return 8 * (i >> 2) + 4 * n + (i & 3); }

struct Unit { int pm, pn, kind; const char* a; const char* b; };

struct TileOrder {
    int nM, nN, nwg, G, c;
    __device__ __forceinline__ void init(int nM_, int nN_, int G_, int c_) { nM = nM_; nN = nN_; nwg = nM_ * nN_; G = G_; c = c_; }
    __device__ __forceinline__ bool map(int L, int& pm, int& pn) const {
        if (L >= nwg) return false;
        int wgid = L; { const int q = nwg / 8, r = nwg % 8, xcd = wgid % 8, off = wgid / 8; wgid = (xcd < r ? xcd * (q + 1) : r * (q + 1) + (xcd - r) * q) + off; }
        const int nig = 8 * nN, gid = wgid / nig, fm = gid * 8, gsz = (nM - fm) < 8 ? (nM - fm) : 8;
        pm = fm + ((wgid % nig) % gsz); pn = (wgid % nig) / gsz; return true;
    }
};
struct SchedG {
    TileOrder o; const char* A; const char* B; size_t a_pm, a_pn; int a_sh; size_t b_pn, b_pb;
    __device__ __forceinline__ bool next(int i, Unit& u) const {
        if (!o.map(i * o.G + o.c, u.pm, u.pn)) return false;
        u.kind = 0; u.a = A + (size_t)u.pm * a_pm + (size_t)(u.pn >> a_sh) * a_pn; u.b = B + (size_t)u.pn * b_pn + (size_t)(u.pm >> 5) * b_pb; return true; }
};
struct SchedMerge {
    TileOrder o; const char* A1; const char* B1; const char* A2; const char* B2;
    __device__ __forceinline__ bool next(int i, Unit& u) const {
        if (!o.map((i >> 1) * o.G + o.c, u.pm, u.pn)) return false;
        u.kind = i & 1; const size_t ts = (size_t)256 * 1024 * 2;
        u.a = (u.kind ? A2 : A1) + (size_t)u.pm * ts; u.b = (u.kind ? B2 : B1) + (size_t)u.pn * ts; return true; }
};
struct SchedProj {
    TileOrder o; const char* xb; const char* win; const char* memb; const char* wk; const char* wv;
    __device__ __forceinline__ bool next(int i, Unit& u) const {
        const int L = i * o.G + o.c; const size_t ts = (size_t)256 * 1024 * 2;
        if (o.map(L, u.pm, u.pn)) { u.kind = 0; u.a = xb + (size_t)u.pm * ts; u.b = win + (size_t)u.pn * ts; return true; }
        const int e = L - o.nwg; if (e >= 0) return false;
        if (e < 16) { u.kind = 1; u.pm = e >> 2; u.pn = e & 3; u.a = memb + (size_t)u.pm * ts; u.b = wk + (size_t)u.pn * ts; }
        else { const int f = e - 16; u.kind = 2; u.pm = f >> 2; u.pn = f & 3; u.a = memb + (size_t)u.pm * ts; u.b = wv + (size_t)u.pn * ts; }
        return true; }
};

typedef f32x4 Acc[2][2][4][2];

template <class Epi, class Sched>
__device__ __forceinline__ void gemm_phase(LAS unsigned char* lds, const int lda, const int ldb, const int K, const Sched& S, const Epi& E) {
    int tid_ = threadIdx.x; asm volatile("" : "+v"(tid_));
    const int tid = tid_, wid = __builtin_amdgcn_readfirstlane(tid >> 6), lane = tid & 63, wr = wid >> 2, wc = wid & 3, fr = lane & 15, fq = lane >> 4;
    const int nt = K / BK;
    unsigned voffA[2], voffB[2];
#pragma unroll
    for (int i = 0; i < 2; ++i) { int R, C; stage_rc(tid * 16 + i * 8192, R, C); const int Rb = (R & ~31) + perm32(R & 31);
        voffA[i] = (unsigned)(R * lda + C) * 2u; voffB[i] = (unsigned)(Rb * ldb + C) * 2u; }
    const size_t kstep = (size_t)(BK * 2);
    const size_t hstepA = (size_t)HALF * lda * 2, hstepB = (size_t)HALF * ldb * 2;
    const unsigned ldsw = (unsigned)wid * 1024u;
    const int aoff = lds_byte(wr * 64 + fr, fq * 8), boff = lds_byte(wc * 32 + fr, fq * 8);
    LAS unsigned char* xl = lds + LDS_STAGE;
#define PG8_SA(b, h) (((b) * 2 + (h)) * HTB)
#define PG8_SB(b, h) ((4 + (b) * 2 + (h)) * HTB)
#define PG8_STAGE(bufoff, gbase, voff) do { _Pragma("unroll") for (int _i = 0; _i < 2; ++_i) \
        __builtin_amdgcn_global_load_lds((const unsigned*)((const char*)(gbase) + (voff)[_i]), (LAS unsigned*)(lds + (bufoff) + ldsw + _i * 8192), 16, 0, 0); } while (0)
#define PG8_LDA(dst, b, h) do { _Pragma("unroll") for (int m = 0; m < 4; ++m) _Pragma("unroll") for (int k = 0; k < 2; ++k) dst[m][k] = *(const LAS bf16x8*)(lds + PG8_SA(b, h) + aoff + m * 2048 + k * 1024); } while (0)
#define PG8_LDB(dst, b, h) do { _Pragma("unroll") for (int n = 0; n < 2; ++n) _Pragma("unroll") for (int k = 0; k < 2; ++k) dst[n][k] = *(const LAS bf16x8*)(lds + PG8_SB(b, h) + boff + n * 2048 + k * 1024); } while (0)
#define PG8_MMA(ai, bj, At, Bt) do { __builtin_amdgcn_s_setprio(1); _Pragma("unroll") for (int m = 0; m < 4; ++m) _Pragma("unroll") for (int n = 0; n < 2; ++n) _Pragma("unroll") for (int k = 0; k < 2; ++k) \
        acc[ai][bj][m][n] = __builtin_amdgcn_mfma_f32_16x16x32_bf16(Bt[n][k], At[m][k], acc[ai][bj][m][n], 0, 0, 0); __builtin_amdgcn_s_setprio(0); } while (0)
#define PG8_WAIT_V(n) asm volatile("s_waitcnt vmcnt(" #n ")" ::: "memory")
#define PG8_WAIT_L(n) asm volatile("s_waitcnt lgkmcnt(" #n ")" ::: "memory")
#define PG8_BAR __builtin_amdgcn_s_barrier()
#define PG8_SCHED __builtin_amdgcn_sched_barrier(0)
    Unit cur, nxt; int ui = 0;
    if (!S.next(0, cur)) return;
    Acc acc;
#pragma unroll
    for (int a = 0; a < 2; ++a)
#pragma unroll
        for (int b = 0; b < 2; ++b)
#pragma unroll
            for (int m = 0; m < 4; ++m)
#pragma unroll
                for (int n = 0; n < 2; ++n) acc[a][b][m][n] = (f32x4){0.f, 0.f, 0.f, 0.f};
    bf16x8 At[4][2], B0[2][2], B1[2][2];
    const char* cA = cur.a; const char* cB = cur.b;
    PG8_STAGE(PG8_SB(0, 0), cB, voffB); PG8_STAGE(PG8_SB(0, 1), cB + hstepB, voffB); PG8_STAGE(PG8_SA(0, 0), cA, voffA); PG8_STAGE(PG8_SA(0, 1), cA + hstepA, voffA);
    if (wr == 1) PG8_BAR;
    PG8_WAIT_V(2); PG8_BAR;
    PG8_STAGE(PG8_SB(1, 0), cB + kstep, voffB); PG8_STAGE(PG8_SA(1, 0), cA + kstep, voffA); PG8_STAGE(PG8_SB(1, 1), cB + hstepB + kstep, voffB);
    PG8_WAIT_V(6); PG8_BAR;
    for (;;) {
        const bool has_next = S.next(ui + 1, nxt);
        const char* nA = has_next ? nxt.a : cA; const char* nB = has_next ? nxt.b : cB;
#pragma unroll 1
        for (int t = 0; t < nt; t += 2) {
            const bool last = (t == nt - 2);
            const char* a1 = cA + (size_t)(t + 1) * kstep;
            const char* a2 = last ? nA : cA + (size_t)(t + 2) * kstep; const char* b2 = last ? nB : cB + (size_t)(t + 2) * kstep;
            const char* a3 = a2 + kstep; const char* b3 = b2 + kstep;
            PG8_LDB(B0, 0, 0); PG8_LDB(B1, 0, 1); PG8_SCHED; PG8_LDA(At, 0, 0); PG8_STAGE(PG8_SA(1, 1), a1 + hstepA, voffA);
            PG8_WAIT_V(8); PG8_WAIT_L(0); PG8_BAR; PG8_MMA(0, 0, At, B0); PG8_MMA(0, 1, At, B1); PG8_BAR; PG8_SCHED;
            PG8_LDA(At, 0, 1); PG8_STAGE(PG8_SB(0, 0), b2, voffB); PG8_STAGE(PG8_SB(0, 1), b2 + hstepB, voffB); PG8_STAGE(PG8_SA(0, 0), a2, voffA);
            PG8_WAIT_V(8); PG8_WAIT_L(0); PG8_BAR; PG8_MMA(1, 0, At, B0); PG8_MMA(1, 1, At, B1); PG8_BAR; PG8_SCHED;
            PG8_LDB(B0, 1, 0); PG8_LDB(B1, 1, 1); PG8_SCHED; PG8_LDA(At, 1, 0); PG8_STAGE(PG8_SA(0, 1), a2 + hstepA, voffA);
            PG8_WAIT_V(8); PG8_WAIT_L(0); PG8_BAR; PG8_MMA(0, 0, At, B0); PG8_MMA(0, 1, At, B1); PG8_BAR; PG8_SCHED;
            PG8_LDA(At, 1, 1); PG8_STAGE(PG8_SB(1, 0), b3, voffB); PG8_STAGE(PG8_SB(1, 1), b3 + hstepB, voffB); PG8_STAGE(PG8_SA(1, 0), a3, voffA);
            PG8_WAIT_V(8); PG8_WAIT_L(0); PG8_BAR; PG8_MMA(1, 0, At, B0); PG8_MMA(1, 1, At, B1); PG8_BAR; PG8_SCHED;
        }
        if (wr == 0) PG8_BAR;
        const bool keep = E(acc, cur, wr, wc, fr, fq, xl);
        if (!has_next) break;
        if (!keep) {
#pragma unroll
            for (int a = 0; a < 2; ++a)
#pragma unroll
                for (int b = 0; b < 2; ++b)
#pragma unroll
                    for (int m = 0; m < 4; ++m)
#pragma unroll
                        for (int n = 0; n < 2; ++n) acc[a][b][m][n] = (f32x4){0.f, 0.f, 0.f, 0.f};
        }
        cur = nxt; cA = nA; cB = nB; ++ui;
        if (wr == 1) PG8_BAR;
    }
    PG8_WAIT_V(0);
    PG8_BAR;
#undef PG8_SA
#undef PG8_SB
#undef PG8_STAGE
#undef PG8_LDA
#undef PG8_LDB
#undef PG8_MMA
#undef PG8_WAIT_V
#undef PG8_WAIT_L
#undef PG8_BAR
#undef PG8_SCHED
}

#define EPI_GEOM int lo; asm volatile("v_mbcnt_lo_u32_b32 %0, -1, 0\n\tv_mbcnt_hi_u32_b32 %0, -1, %0" : "=v"(lo)); (void)fr; (void)fq; \
    const int fr_ = lo & 15, fq_ = lo >> 4; const int row0 = u.pm * 256 + wr * 64 + fr_, colw = wc * 32 + 8 * fq_
#define ACC8(v, ai, bj, m) float v[8] = {acc[ai][bj][m][0][0], acc[ai][bj][m][0][1], acc[ai][bj][m][0][2], acc[ai][bj][m][0][3], acc[ai][bj][m][1][0], acc[ai][bj][m][1][1], acc[ai][bj][m][1][2], acc[ai][bj][m][1][3]}

struct EpiProj {
    bf16_t* slots; const float* bmerge; bf16_t* kb; bf16_t* vt;
    __device__ __forceinline__ bool operator()(Acc& acc, const Unit& u, int wr, int wc, int fr, int fq, LAS unsigned char*) const {
        EPI_GEOM;
        bf16_t* base; int ldc, act = 0; const float* bias = nullptr;
        if (u.kind == 0) { const int seg = u.pn >> 2; base = slots + (size_t)seg * (SLOT / 2) + (u.pn & 3) * 256; ldc = 1024;
            act = (seg == 0) ? 1 : (seg >= 5 ? 2 : 0); if (seg >= 5) bias = bmerge + (seg - 5) * 1024 + (u.pn & 3) * 256; }
        else if (u.kind == 1) { base = kb + u.pn * 256; ldc = 1024; }
        else { base = vt + u.pn * 256; ldc = 1024; }
        if (u.kind == 0 && u.pn >= 12 && u.pn < 20) {
            bf16_t* pb = slots + (size_t)3 * (SLOT / 2) + (u.pn - 12) * 128 + colw;
#pragma unroll
            for (int ai = 0; ai < 2; ++ai)
#pragma unroll
                for (int m = 0; m < 4; ++m) { ACC8(vc, ai, 0, m); ACC8(vh, ai, 1, m);
#pragma unroll
                    for (int j = 0; j < 8; ++j) vc[j] *= vh[j];
                    *(u32x4*)(pb + (size_t)(row0 + ai * 128 + m * 16) * 1024) = pack8(vc); }
            return false;
        }
#pragma unroll
        for (int bj = 0; bj < 2; ++bj) {
            float bv[8];
#pragma unroll
            for (int j = 0; j < 8; ++j) bv[j] = 0.f;
            if (act == 2) { const f32x4 b0 = *(const f32x4*)(bias + colw + bj * 128), b1 = *(const f32x4*)(bias + colw + bj * 128 + 4);
#pragma unroll
                for (int j = 0; j < 4; ++j) { bv[j] = b0[j]; bv[4 + j] = b1[j]; } }
#pragma unroll
            for (int ai = 0; ai < 2; ++ai)
#pragma unroll
                for (int m = 0; m < 4; ++m) { ACC8(v, ai, bj, m);
                    if (act == 1) {
#pragma unroll
                        for (int j = 0; j < 8; ++j) v[j] = gelu_tanh(v[j]); }
                    else if (act == 2) {
#pragma unroll
                        for (int j = 0; j < 8; ++j) v[j] = sigmoidf_(v[j] + bv[j]); }
                    *(u32x4*)(base + (size_t)(row0 + ai * 128 + m * 16) * ldc + colw + bj * 128) = pack8(v); }
        }
        return false;
    }
};
struct EpiBf16 {
    bf16_t* out; int ldc; float scale;
    __device__ __forceinline__ bool operator()(Acc& acc, const Unit& u, int wr, int wc, int fr, int fq, LAS unsigned char*) const {
        EPI_GEOM;
#pragma unroll
        for (int ai = 0; ai < 2; ++ai)
#pragma unroll
            for (int m = 0; m < 4; ++m)
#pragma unroll
                for (int bj = 0; bj < 2; ++bj) { ACC8(v, ai, bj, m);
#pragma unroll
                    for (int j = 0; j < 8; ++j) v[j] *= scale;
                    *(u32x4*)(out + (size_t)(row0 + ai * 128 + m * 16) * ldc + u.pn * 256 + colw + bj * 128) = pack8(v); }
        return false;
    }
};
struct EpiGates {
    const bf16_t* ub; const float* br; const float* bi; const float* sp; unsigned short* la; unsigned short* bt;
    __device__ __forceinline__ bool operator()(Acc& acc, const Unit& u, int wr, int wc, int fr, int fq, LAS unsigned char*) const {
        EPI_GEOM;
#pragma unroll
        for (int n = 0; n < 2; ++n) { const int ch = u.pn * 128 + colw + 4 * n;
            const f32x4 vbr = *(const f32x4*)(br + ch), vbi = *(const f32x4*)(bi + ch), vsp = *(const f32x4*)(sp + ch);
            u32x2 uws[2][4];
#pragma unroll
            for (int ai = 0; ai < 2; ++ai)
#pragma unroll
                for (int m = 0; m < 4; ++m) uws[ai][m] = *(const u32x2*)(ub + (size_t)(row0 + ai * 128 + m * 16) * 1024 + ch);
#pragma unroll
            for (int ai = 0; ai < 2; ++ai)
#pragma unroll
                for (int m = 0; m < 4; ++m) { const int row = row0 + ai * 128 + m * 16; const bool first = (row & (SEQ - 1)) == 0;
                    const u32x2 uw = uws[ai][m]; const float uu[4] = {bf_lo(uw.x), bf_hi(uw.x), bf_lo(uw.y), bf_hi(uw.y)};
                    float l[4], b[4];
                    float yy[4], ig4[4];
#pragma unroll
                    for (int j = 0; j < 4; ++j) {
                        const float ea = __builtin_amdgcn_exp2f(fminf(-1.4426950408889634f * (acc[ai][0][m][n][j] + vbr[j]), 60.f)), eb = __builtin_amdgcn_exp2f(fminf(-1.4426950408889634f * (acc[ai][1][m][n][j] + vbi[j]), 60.f));
                        const float da = 1.0f + ea, db = 1.0f + eb, rr = __builtin_amdgcn_rcpf(da * db); const float r = rr * db; ig4[j] = rr * da; l[j] = vsp[j] * r; yy[j] = 2.0f * l[j]; }
                    const bool small = __builtin_amdgcn_ballot_w64(fminf(fminf(yy[0], yy[1]), fminf(yy[2], yy[3])) < -0.25f) == 0ull;
#pragma unroll
                    for (int j = 0; j < 4; ++j) { const float y = yy[j];
                        const float em = small ? -y * (1.0f + y * (0.5f + y * (0.16666667f + y * (0.041666668f + y * (0.0083333338f + y * (0.0013888889f + y * 0.0001984127f)))))) : 1.0f - __builtin_amdgcn_exp2f(1.4426950408889634f * y);
                        const float mult = first ? 1.0f : __builtin_amdgcn_sqrtf(em); b[j] = mult * ig4[j] * uu[j]; }
                    u32x2 wl, wb; wl.x = pack_h2(l[0], l[1]); wl.y = pack_h2(l[2], l[3]); wb.x = pack_h2(b[0], b[1]); wb.y = pack_h2(b[2], b[3]);
                    *(u32x2*)(la + (size_t)row * 1024 + ch) = wl; *(u32x2*)(bt + (size_t)row * 1024 + ch) = wb;
                    asm volatile("" ::: "memory"); }
        }
        return false;
    }
};
struct EpiMerge {
    const bf16_t* g1; const bf16_t* g2; bf16_t* out;
    __device__ __forceinline__ bool operator()(Acc& acc, const Unit& u, int wr, int wc, int fr, int fq, LAS unsigned char*) const {
        EPI_GEOM;
#pragma unroll
        for (int ai = 0; ai < 2; ++ai)
#pragma unroll
            for (int m = 0; m < 4; ++m)
#pragma unroll
                for (int bj = 0; bj < 2; ++bj) { const size_t off = (size_t)(row0 + ai * 128 + m * 16) * 1024 + u.pn * 256 + colw + bj * 128;
                    float b[8]; unpack8(*(const u32x4*)(g2 + off), b);
                    if (u.kind == 0) { float a[8]; unpack8(*(const u32x4*)(g1 + off), a);
#pragma unroll
                        for (int j = 0; j < 4; ++j) { acc[ai][bj][m][0][j] *= a[j] * __builtin_amdgcn_rcpf(b[j]); acc[ai][bj][m][1][j] *= a[4 + j] * __builtin_amdgcn_rcpf(b[4 + j]); } }
                    else { ACC8(v, ai, bj, m);
#pragma unroll
                        for (int j = 0; j < 8; ++j) v[j] *= b[j];
                        *(u32x4*)(out + off) = pack8(v); } }
        return u.kind == 0;
    }
};
struct EpiRes {
    const float* res; unsigned short* outh;
    __device__ __forceinline__ bool operator()(Acc& acc, const Unit& u, int wr, int wc, int fr, int fq, LAS unsigned char*) const {
        EPI_GEOM;
#pragma unroll
        for (int ai = 0; ai < 2; ++ai)
#pragma unroll
            for (int bj = 0; bj < 2; ++bj) { const size_t off0 = (size_t)(row0 + ai * 128) * 1024 + u.pn * 256 + colw + bj * 128;
                f32x4 r0[4], r1[4];
#pragma unroll
                for (int m = 0; m < 4; ++m) { r0[m] = __builtin_nontemporal_load((const f32x4*)(res + off0 + (size_t)m * 16 * 1024)); r1[m] = __builtin_nontemporal_load((const f32x4*)(res + off0 + (size_t)m * 16 * 1024 + 4)); }
#pragma unroll
                for (int m = 0; m < 4; ++m) { const f32x4 t0 = r0[m] * ALPHA + acc[ai][bj][m][0], t1 = r1[m] * ALPHA + acc[ai][bj][m][1];
                    u32x4 w; w.x = pack_h2(t0[0], t0[1]); w.y = pack_h2(t0[2], t0[3]); w.z = pack_h2(t1[0], t1[1]); w.w = pack_h2(t1[2], t1[3]);
                    *(u32x4*)(outh + off0 + (size_t)m * 16 * 1024) = w; }
                asm volatile("" ::: "memory"); }
        return false;
    }
};
struct EpiResB {
    const bf16_t* resb; unsigned short* outh;
    __device__ __forceinline__ bool operator()(Acc& acc, const Unit& u, int wr, int wc, int fr, int fq, LAS unsigned char*) const {
        EPI_GEOM;
#pragma unroll
        for (int ai = 0; ai < 2; ++ai) { const size_t off0 = (size_t)(row0 + ai * 128) * 1024 + u.pn * 256 + colw;
            u32x4 rb[4][2];
#pragma unroll
            for (int m = 0; m < 4; ++m)
#pragma unroll
                for (int bj = 0; bj < 2; ++bj) rb[m][bj] = __builtin_nontemporal_load((const u32x4*)(resb + off0 + (size_t)m * 16 * 1024 + bj * 128));
#pragma unroll
            for (int m = 0; m < 4; ++m)
#pragma unroll
                for (int bj = 0; bj < 2; ++bj) { float r[8]; unpack8(rb[m][bj], r);
                    const f32x4 t0 = (f32x4){r[0], r[1], r[2], r[3]} * ALPHA + acc[ai][bj][m][0], t1 = (f32x4){r[4], r[5], r[6], r[7]} * ALPHA + acc[ai][bj][m][1];
                    u32x4 w; w.x = pack_h2(t0[0], t0[1]); w.y = pack_h2(t0[2], t0[3]); w.z = pack_h2(t1[0], t1[1]); w.w = pack_h2(t1[2], t1[3]);
                    *(u32x4*)(outh + off0 + (size_t)m * 16 * 1024 + bj * 128) = w; }
            asm volatile("" ::: "memory"); }
        return false;
    }
};
struct EpiScore {
    bf16_t* P; float* rs;
    __device__ __forceinline__ bool operator()(Acc& acc, const Unit& u, int wr, int wc, int fr, int fq, LAS unsigned char* xl) const {
        EPI_GEOM; LAS float* mx = (LAS float*)xl;
#pragma unroll
        for (int ai = 0; ai < 2; ++ai)
#pragma unroll
            for (int m = 0; m < 4; ++m) { float mv = -3.0e38f;
#pragma unroll
                for (int bj = 0; bj < 2; ++bj)
#pragma unroll
                    for (int n = 0; n < 2; ++n)
#pragma unroll
                        for (int j = 0; j < 4; ++j) mv = fmaxf(mv, acc[ai][bj][m][n][j]);
                mv = fmaxf(mv, bperm_xor(mv, lo, 16)); mv = fmaxf(mv, bperm_xor(mv, lo, 32));
                if (fq_ == 0) mx[(ai * 128 + wr * 64 + m * 16 + fr_) * 4 + wc] = mv; }
        asm volatile("s_waitcnt lgkmcnt(0)" ::: "memory"); __builtin_amdgcn_s_barrier(); asm volatile("" ::: "memory");
#pragma unroll
        for (int ai = 0; ai < 2; ++ai)
#pragma unroll
            for (int m = 0; m < 4; ++m) { const int rl = ai * 128 + wr * 64 + m * 16 + fr_; const f32x4 q = *(const LAS f32x4*)(mx + rl * 4);
                const float mv = fmaxf(fmaxf(q[0], q[1]), fmaxf(q[2], q[3])) * 1.4426950408889634f; float sum = 0.f;
#pragma unroll
                for (int bj = 0; bj < 2; ++bj) { ACC8(v, ai, bj, m);
#pragma unroll
                    for (int j = 0; j < 8; ++j) v[j] = __builtin_amdgcn_exp2f(v[j] * 1.4426950408889634f - mv);
                    const u32x4 w = pack8(v); float r[8]; unpack8(w, r);
#pragma unroll
                    for (int j = 0; j < 8; ++j) sum += r[j];
                    *(u32x4*)(P + (size_t)(row0 + ai * 128 + m * 16) * 1024 + u.pn * 256 + colw + bj * 128) = w; }
                sum += bperm_xor(sum, lo, 16); sum += bperm_xor(sum, lo, 32);
                if (fq_ == 0) rs[((size_t)u.pn * MT + (row0 + ai * 128 + m * 16)) * 4 + wc] = sum;
                asm volatile("" ::: "memory"); }
        return false;
    }
};

struct SchedPre {
    int G, c; const char* kb; const char* wq; const char* wxo; const char* vb;
    __device__ __forceinline__ bool next(int i, Unit& u) const {
        const int L = i * G + c; if (L >= 128) return false;
        const int t = L & 63, b = t >> 4, h = (t >> 2) & 3, nt = t & 3; const size_t ts = (size_t)256 * 1024 * 2;
        u.kind = L >> 6; u.pm = (b << 2) | h; u.pn = nt;
        if (u.kind == 0) { u.a = kb + (size_t)b * ts + h * 512; u.b = wq + (size_t)nt * ts + h * 512; }
        else { u.a = wxo + (size_t)nt * ts + h * 512; u.b = vb + (size_t)b * ts + h * 512; }
        return true; }
};
struct EpiPre {
    bf16_t* gb; bf16_t* vwb;
    __device__ __forceinline__ bool operator()(Acc& acc, const Unit& u, int wr, int wc, int fr, int fq, LAS unsigned char*) const {
        EPI_GEOM; const int b = u.pm >> 2, h = u.pm & 3;
        bf16_t* base = (u.kind == 0) ? gb + (size_t)u.pm * 256 * 1024 + u.pn * 256 : vwb + (size_t)b * 1024 * 1024 + (size_t)u.pn * 256 * 1024 + h * 256;
        const float scale = (u.kind == 0) ? 0.0625f : 1.0f; const int rl0 = wr * 64 + fr_;
#pragma unroll
        for (int ai = 0; ai < 2; ++ai)
#pragma unroll
            for (int m = 0; m < 4; ++m)
#pragma unroll
                for (int bj = 0; bj < 2; ++bj) { ACC8(v, ai, bj, m);
#pragma unroll
                    for (int j = 0; j < 8; ++j) v[j] *= scale;
                    *(u32x4*)(base + (size_t)(rl0 + ai * 128 + m * 16) * 1024 + colw + bj * 128) = pack8(v); }
        (void)row0;
        return false;
    }
};
struct EpiScoreN {
    bf16_t* P;
    __device__ __forceinline__ bool operator()(Acc& acc, const Unit& u, int wr, int wc, int fr, int fq, LAS unsigned char* xl) const {
        EPI_GEOM; LAS float* mx = (LAS float*)xl; LAS float* sx = (LAS float*)(xl + 4096);
#pragma unroll
        for (int ai = 0; ai < 2; ++ai)
#pragma unroll
            for (int m = 0; m < 4; ++m) { float mv = -3.0e38f;
#pragma unroll
                for (int bj = 0; bj < 2; ++bj)
#pragma unroll
                    for (int n = 0; n < 2; ++n)
#pragma unroll
                        for (int j = 0; j < 4; ++j) mv = fmaxf(mv, acc[ai][bj][m][n][j]);
                mv = fmaxf(mv, bperm_xor(mv, lo, 16)); mv = fmaxf(mv, bperm_xor(mv, lo, 32));
                if (fq_ == 0) mx[(ai * 128 + wr * 64 + m * 16 + fr_) * 4 + wc] = mv; }
        asm volatile("s_waitcnt lgkmcnt(0)" ::: "memory"); __builtin_amdgcn_s_barrier(); asm volatile("" ::: "memory");
#pragma unroll
        for (int ai = 0; ai < 2; ++ai)
#pragma unroll
            for (int m = 0; m < 4; ++m) { const int rl = ai * 128 + wr * 64 + m * 16 + fr_; const f32x4 q = *(const LAS f32x4*)(mx + rl * 4);
                const float mv = fmaxf(fmaxf(q[0], q[1]), fmaxf(q[2], q[3])) * 1.4426950408889634f; float sum = 0.f;
#pragma unroll
                for (int bj = 0; bj < 2; ++bj)
#pragma unroll
                    for (int n = 0; n < 2; ++n)
#pragma unroll
                        for (int j = 0; j < 4; ++j) { const float e = __builtin_amdgcn_exp2f(acc[ai][bj][m][n][j] * 1.4426950408889634f - mv); acc[ai][bj][m][n][j] = e; sum += e; }
                sum += bperm_xor(sum, lo, 16); sum += bperm_xor(sum, lo, 32);
                if (fq_ == 0) sx[rl * 4 + wc] = sum; }
        asm volatile("s_waitcnt lgkmcnt(0)" ::: "memory"); __builtin_amdgcn_s_barrier(); asm volatile("" ::: "memory");
#pragma unroll
        for (int ai = 0; ai < 2; ++ai)
#pragma unroll
            for (int m = 0; m < 4; ++m) { const int rl = ai * 128 + wr * 64 + m * 16 + fr_; const f32x4 q = *(const LAS f32x4*)(sx + rl * 4);
                const float inv = __builtin_amdgcn_rcpf((q[0] + q[1]) + (q[2] + q[3]));
#pragma unroll
                for (int bj = 0; bj < 2; ++bj) { ACC8(v, ai, bj, m);
#pragma unroll
                    for (int j = 0; j < 8; ++j) v[j] *= inv;
                    *(u32x4*)(P + (size_t)(row0 + ai * 128 + m * 16) * 1024 + u.pn * 256 + colw + bj * 128) = pack8(v); }
                asm volatile("" ::: "memory"); }
        return false;
    }
};

struct SchedKVS {
    int G, c; const char* memb; const char* wk; const char* wv;
    __device__ __forceinline__ bool next(int i, Unit& u) const {
        const int L = i * G + c; if (L >= 128) return false;
        const int mat = L >> 6, rt = (L >> 4) & 3, ct = (L >> 2) & 3, ks = L & 3; const size_t ts = (size_t)256 * 1024 * 2;
        u.kind = mat * 4 + ks; u.pm = rt; u.pn = ct; u.a = memb + (size_t)rt * ts + ks * 512; u.b = (mat ? wv : wk) + (size_t)ct * ts + ks * 512; return true; }
};
struct EpiPart {
    float* part;
    __device__ __forceinline__ bool operator()(Acc& acc, const Unit& u, int wr, int wc, int fr, int fq, LAS unsigned char*) const {
        EPI_GEOM; float* base = part + (size_t)u.kind * 1024 * 1024;
#pragma unroll
        for (int ai = 0; ai < 2; ++ai)
#pragma unroll
            for (int m = 0; m < 4; ++m)
#pragma unroll
                for (int bj = 0; bj < 2; ++bj) { float* q = base + (size_t)(row0 + ai * 128 + m * 16) * 1024 + u.pn * 256 + colw + bj * 128;
                    *(f32x4*)q = acc[ai][bj][m][0]; *(f32x4*)(q + 4) = acc[ai][bj][m][1]; }
        return false;
    }
};
struct EpiPV {
    const float* rs; bf16_t* out;
    __device__ __forceinline__ bool operator()(Acc& acc, const Unit& u, int wr, int wc, int fr, int fq, LAS unsigned char*) const {
        EPI_GEOM;
#pragma unroll
        for (int ai = 0; ai < 2; ++ai)
#pragma unroll
            for (int m = 0; m < 4; ++m) { const int row = row0 + ai * 128 + m * 16; const f32x4 q = *(const f32x4*)(rs + ((size_t)u.pn * MT + row) * 4);
                const float inv = 1.0f / ((q[0] + q[1]) + (q[2] + q[3]));
#pragma unroll
                for (int bj = 0; bj < 2; ++bj) { ACC8(v, ai, bj, m);
#pragma unroll
                    for (int j = 0; j < 8; ++j) v[j] *= inv;
                    *(u32x4*)(out + (size_t)row * 1024 + u.pn * 256 + colw + bj * 128) = pack8(v); } }
        return false;
    }
};
__device__ __forceinline__ unsigned ror_row(unsigned v, const int n) { return (unsigned)(n == 1 ? __builtin_amdgcn_update_dpp(0, (int)v, 0x121, 0xf, 0xf, false) : __builtin_amdgcn_update_dpp(0, (int)v, 0x122, 0xf, 0xf, false)); }
struct EpiFfnUp {
    const bf16_t* g; const float* cw; const float* cb; bf16_t* out;
    __device__ __forceinline__ bool operator()(Acc& acc, const Unit& u, int wr, int wc, int fr, int fq, LAS unsigned char*) const {
        EPI_GEOM;
#pragma unroll
        for (int bj = 0; bj < 2; ++bj) { const int col = u.pn * 256 + colw + bj * 128;
            float w0[8], w1[8], w2[8], bb[8];
            { const f32x4 a0 = *(const f32x4*)(cw + col), a1 = *(const f32x4*)(cw + col + 4), b0 = *(const f32x4*)(cw + DFF + col), b1 = *(const f32x4*)(cw + DFF + col + 4),
                          c0 = *(const f32x4*)(cw + 2 * DFF + col), c1 = *(const f32x4*)(cw + 2 * DFF + col + 4), d0 = *(const f32x4*)(cb + col), d1 = *(const f32x4*)(cb + col + 4);
#pragma unroll
              for (int j = 0; j < 4; ++j) { w0[j] = a0[j]; w0[4 + j] = a1[j]; w1[j] = b0[j]; w1[4 + j] = b1[j]; w2[j] = c0[j]; w2[4 + j] = c1[j]; bb[j] = d0[j]; bb[4 + j] = d1[j]; } }
#pragma unroll
            for (int ai = 0; ai < 2; ++ai) { const int R = u.pm * 256 + ai * 128 + wr * 64;
                u32x4 G0[4], H1 = (u32x4){0u, 0u, 0u, 0u}, H2 = (u32x4){0u, 0u, 0u, 0u};
#pragma unroll
                for (int m = 0; m < 4; ++m) G0[m] = __builtin_nontemporal_load((const u32x4*)(g + (size_t)(R + m * 16 + fr_) * DFF + col));
                if ((R & (SEQ - 1)) != 0) { H1 = *(const u32x4*)(g + (size_t)(R - 1) * DFF + col); H2 = *(const u32x4*)(g + (size_t)(R - 2) * DFF + col); }
                u32x4 prev;
#pragma unroll
                for (int j = 0; j < 4; ++j) prev[j] = (fr_ == 15) ? H1[j] : H2[j];
#pragma unroll
                for (int m = 0; m < 4; ++m) { const int row = row0 + ai * 128 + m * 16; const u32x4 cur = G0[m]; u32x4 t1, t2;
#pragma unroll
                    for (int j = 0; j < 4; ++j) { const unsigned c1r = ror_row(cur[j], 1), p1r = ror_row(prev[j], 1), c2r = ror_row(cur[j], 2), p2r = ror_row(prev[j], 2);
                        t1[j] = (fr_ == 0) ? p1r : c1r; t2[j] = (fr_ < 2) ? p2r : c2r; }
                    float g0[8], g1[8], g2[8]; unpack8(cur, g0); unpack8(t1, g1); unpack8(t2, g2);
                    ACC8(v, ai, bj, m);
#pragma unroll
                    for (int j = 0; j < 8; ++j) { const float gate = w0[j] * g0[j] + w1[j] * g1[j] + w2[j] * g2[j] + bb[j]; v[j] *= gelu_tanh(gate); }
                    *(u32x4*)(out + (size_t)row * DFF + col) = pack8(v);
                    prev = cur; }
                asm volatile("" ::: "memory");
            }
        }
        return false;
    }
};

struct Params { const float* in[30]; float* out; unsigned char* ws; };

__device__ __forceinline__ void transpose_cvt(const float* __restrict__ src, bf16_t* __restrict__ dst, int K, int N, LAS float* tiles, int& job, const bool pair_sc = false) {
    const int tid = tid_opaque(), lane = tid & 63, wv = tid >> 6, tk = K / 64, tn = N / 64, ntile = tk * tn, nwv = (int)gridDim.x * 8, me = (int)blockIdx.x * 8 + wv;
    LAS float* tile = tiles + wv * (64 * 65);
    const int first = ((me - (job % nwv)) % nwv + nwv) % nwv;
    job += ntile;
    for (int t = first; t < ntile; t += nwv) {
        const int k0 = (t / tn) * 64, n0 = (t % tn) * 64;
        int nd = n0; if (pair_sc && n0 >= 3072 && n0 < 5120) { const int sg = (n0 - 3072) >> 10, ch = (n0 - 3072) & 1023; nd = 3072 + (ch >> 7) * 256 + sg * 128 + (ch & 127); }
        f32x4 v[16];
#pragma unroll
        for (int it = 0; it < 16; ++it) v[it] = __builtin_nontemporal_load((const f32x4*)(src + (size_t)(k0 + it * 4 + (lane >> 4)) * N + n0 + (lane & 15) * 4));
#pragma unroll
        for (int it = 0; it < 16; ++it) { const int r = it * 4 + (lane >> 4), c4 = (lane & 15) * 4;
            tile[r * 65 + c4 + 0] = v[it][0]; tile[r * 65 + c4 + 1] = v[it][1]; tile[r * 65 + c4 + 2] = v[it][2]; tile[r * 65 + c4 + 3] = v[it][3]; }
        asm volatile("s_waitcnt lgkmcnt(0)" ::: "memory");
#pragma unroll
        for (int it = 0; it < 8; ++it) { const int n = it * 8 + (lane >> 3), k8 = (lane & 7) * 8; float f[8];
#pragma unroll
            for (int q = 0; q < 8; ++q) f[q] = tile[(k8 + q) * 65 + n];
            *(u32x4*)(dst + (size_t)(nd + n) * K + k0 + k8) = pack8(f); }
        asm volatile("s_waitcnt lgkmcnt(0)" ::: "memory");
    }
}
__device__ __forceinline__ void cvt_rows(const float* __restrict__ src, bf16_t* __restrict__ dst, size_t n8) {
    const size_t G_ = gridDim.x, per0 = (n8 + G_ - 1) / G_, base = (size_t)vblk() * per0, per = base >= n8 ? 0 : (n8 - base < per0 ? n8 - base : per0);
    for (size_t i = tid_opaque(); i < per; i += 4 * 512) { f32x4 a[4], b[4];
#pragma unroll
        for (int q = 0; q < 4; ++q) { const size_t e = i + q * 512; if (e < per) { a[q] = __builtin_nontemporal_load((const f32x4*)(src + (base + e) * 8)); b[q] = __builtin_nontemporal_load((const f32x4*)(src + (base + e) * 8 + 4)); } }
#pragma unroll
        for (int q = 0; q < 4; ++q) { const size_t e = i + q * 512; if (e < per) { float f[8] = {a[q][0], a[q][1], a[q][2], a[q][3], b[q][0], b[q][1], b[q][2], b[q][3]}; *(u32x4*)(dst + (base + e) * 8) = pack8(f); } } }
}
__device__ __forceinline__ void phase_prep(const Params& p, LAS unsigned char* lds) {
    unsigned char* ws = p.ws; LAS float* tile = (LAS float*)lds; int job = 0;
    cvt_rows(p.in[0], (bf16_t*)p.out, (size_t)MT * DM / 8);
    cvt_rows(p.in[1], (bf16_t*)(ws + WS_MEMB), (size_t)1024 * DM / 8);
    transpose_cvt(p.in[2], (bf16_t*)(ws + WS_WIN), 1024, 7168, tile, job, true);
    transpose_cvt(p.in[10], (bf16_t*)(ws + WS_WLRU), 1024, 1024, tile, job);
    transpose_cvt(p.in[12], (bf16_t*)(ws + WS_WSC), 1024, 1024, tile, job);
    transpose_cvt(p.in[14], (bf16_t*)(ws + WS_WMIX), 1024, 1024, tile, job);
    cvt_rows(p.in[17], (bf16_t*)(ws + WS_WQ), (size_t)1024 * 1024 / 8);
    transpose_cvt(p.in[18], (bf16_t*)(ws + WS_WK), 1024, 1024, tile, job);
    transpose_cvt(p.in[19], (bf16_t*)(ws + WS_WV), 1024, 1024, tile, job);
    transpose_cvt(p.in[20], (bf16_t*)(ws + WS_WXO), 1024, 1024, tile, job);
    transpose_cvt(p.in[23], (bf16_t*)(ws + WS_WFG), 1024, 3072, tile, job);
    transpose_cvt(p.in[24], (bf16_t*)(ws + WS_WFU), 1024, 3072, tile, job);
    transpose_cvt(p.in[27], (bf16_t*)(ws + WS_WFD), 3072, 1024, tile, job);
    { const float* wr_ = p.in[5]; const float* wi_ = p.in[7]; bf16_t* wg = (bf16_t*)(ws + WS_WG);
      for (int i = blockIdx.x * 512 + tid_opaque(); i < 2048 * 256; i += gridDim.x * 512) { const int kk = i & 255, rowj = i >> 8, h = rowj >> 8, j = rowj & 255, ii = kk - 128 * (h & 1);
          float v = 0.f; if (ii >= 0 && ii < 128) v = (j < 128) ? wr_[(h * 128 + ii) * 128 + j] : wi_[(h * 128 + ii) * 128 + (j - 128)];
          wg[i] = (bf16_t)(cvt_pk_bf16(v, 0.f) & 0xffffu); } }
    { float* sp = (float*)(ws + WS_SP); const float* lam = p.in[9];
      for (int i = blockIdx.x * 512 + tid_opaque(); i < 1024; i += gridDim.x * 512) { const float x = -lam[i]; const float spl = (x > 20.f) ? x : log1pf(expf(x)); sp[i] = -8.0f * spl; } }
}
__device__ __forceinline__ void phase_conv(const Params& p) {
    const bf16_t* PL = (const bf16_t*)(p.ws + WS_SLOT + 1 * SLOT); const bf16_t* PB = (const bf16_t*)(p.ws + WS_SLOT + 2 * SLOT);
    const bf16_t* PP = (const bf16_t*)(p.ws + WS_SLOT + 3 * SLOT);
    bf16_t* S_ = (bf16_t*)p.out; bf16_t* U_ = (bf16_t*)((unsigned char*)p.out + SLOT);
    const float* lw = p.in[3]; const float* lb = p.in[4]; const float* sw = p.in[11];
    for (int idx = vblk() * 512 + tid_opaque(); idx < 1024 * 128; idx += gridDim.x * 512) {
        const int c = (idx & 127) * 8, row0 = (idx >> 7) * 32;
        float w0[8], w1[8], w2[8], w3[8], bb[8], s0[8], s1[8], s2[8];
#pragma unroll
        for (int j = 0; j < 8; ++j) { w0[j] = lw[c + j]; w1[j] = lw[1024 + c + j]; w2[j] = lw[2048 + c + j]; w3[j] = lw[3072 + c + j]; bb[j] = lb[c + j]; s0[j] = sw[c + j]; s1[j] = sw[1024 + c + j]; s2[j] = sw[2048 + c + j]; }
        float l1[8], l2[8], l3[8], p1[8], p2[8];
        if ((row0 & (SEQ - 1)) != 0) { const size_t o = (size_t)row0 * 1024 + c;
            unpack8(*(const u32x4*)(PL + o - 1024), l1); unpack8(*(const u32x4*)(PL + o - 2048), l2); unpack8(*(const u32x4*)(PL + o - 3072), l3);
            unpack8(*(const u32x4*)(PP + o - 1024), p1); unpack8(*(const u32x4*)(PP + o - 2048), p2);
        } else {
#pragma unroll
            for (int j = 0; j < 8; ++j) { l1[j] = 0.f; l2[j] = 0.f; l3[j] = 0.f; p1[j] = 0.f; p2[j] = 0.f; } }
#pragma unroll 4
        for (int t = 0; t < 32; ++t) { const size_t o = (size_t)(row0 + t) * 1024 + c;
            float l0[8], vb[8], vp[8]; unpack8(__builtin_nontemporal_load((const u32x4*)(PL + o)), l0); unpack8(__builtin_nontemporal_load((const u32x4*)(PB + o)), vb); unpack8(__builtin_nontemporal_load((const u32x4*)(PP + o)), vp);
            float uo[8], so[8];
#pragma unroll
            for (int j = 0; j < 8; ++j) { uo[j] = w0[j] * l0[j] + w1[j] * l1[j] + w2[j] * l2[j] + w3[j] * l3[j] + bb[j];
                const float p0 = vp[j]; so[j] = vb[j] * (s0[j] * p0 + s1[j] * p1[j] + s2[j] * p2[j]);
                l3[j] = l2[j]; l2[j] = l1[j]; l1[j] = l0[j]; p2[j] = p1[j]; p1[j] = p0; }
            *(u32x4*)(U_ + o) = pack8(uo); *(u32x4*)(S_ + o) = pack8(so); }
    }
}
__device__ __forceinline__ void phase_scan1(const Params& p) {
    const unsigned* LA = (const unsigned*)(p.ws + WS_SLOT + 1 * SLOT); const unsigned* BT = (const unsigned*)(p.ws + WS_SLOT + 2 * SLOT);
    f32x2* AGA = (f32x2*)(p.ws + WS_AGG); f32x2* AGH = (f32x2*)(p.ws + WS_AGG + MiB);
    for (int idx = vblk() * 512 + tid_opaque(); idx < 256 * 512; idx += gridDim.x * 512) {
        const int cp = idx & 511, ck = idx >> 9; const size_t o0 = (size_t)ck * 128 * 512 + cp;
        f32x2 h = (f32x2){0.f, 0.f}, ls = (f32x2){0.f, 0.f};
#pragma unroll 16
        for (int t = 0; t < 128; ++t) { const f32x2 l = unpack_h2(LA[o0 + (size_t)t * 512]), b = unpack_h2(BT[o0 + (size_t)t * 512]);
            ls += l; h.x = __builtin_amdgcn_exp2f(l.x * 1.4426950408889634f) * h.x + b.x; h.y = __builtin_amdgcn_exp2f(l.y * 1.4426950408889634f) * h.y + b.y; }
        AGA[idx] = ls; AGH[idx] = h;
    }
}
__device__ __forceinline__ void phase_scan3(const Params& p) {
    const unsigned* LA = (const unsigned*)(p.ws + WS_SLOT + 1 * SLOT); const unsigned* BT = (const unsigned*)(p.ws + WS_SLOT + 2 * SLOT);
    const unsigned* PG = (const unsigned*)(p.ws + WS_SLOT + 0 * SLOT); unsigned* YL = (unsigned*)(p.ws + WS_SLOT + 3 * SLOT);
    const f32x2* AGA = (const f32x2*)(p.ws + WS_AGG); const f32x2* AGH = (const f32x2*)(p.ws + WS_AGG + MiB);
    for (int idx = vblk() * 512 + tid_opaque(); idx < 256 * 512; idx += gridDim.x * 512) {
        const int cp = idx & 511, ck = idx >> 9, ckb = ck & ~63; const size_t o0 = (size_t)ck * 128 * 512 + cp;
        f32x2 h = (f32x2){0.f, 0.f};
#pragma unroll 8
        for (int j = ckb; j < ck; ++j) { const f32x2 a = AGA[j * 512 + cp], hh = AGH[j * 512 + cp];
            h.x = __builtin_amdgcn_exp2f(a.x * 1.4426950408889634f) * h.x + hh.x; h.y = __builtin_amdgcn_exp2f(a.y * 1.4426950408889634f) * h.y + hh.y; }
#pragma unroll 16
        for (int t = 0; t < 128; ++t) { const size_t o = o0 + (size_t)t * 512; const f32x2 l = unpack_h2(__builtin_nontemporal_load(LA + o)), b = unpack_h2(__builtin_nontemporal_load(BT + o)); const unsigned gw = __builtin_nontemporal_load(PG + o);
            h.x = __builtin_amdgcn_exp2f(l.x * 1.4426950408889634f) * h.x + b.x; h.y = __builtin_amdgcn_exp2f(l.y * 1.4426950408889634f) * h.y + b.y;
            YL[o] = cvt_pk_bf16(bf_lo(gw) * h.x, bf_hi(gw) * h.y); }
    }
}
__device__ __forceinline__ void phase_ln(const unsigned short* xh, const float* g, const float* b, bf16_t* xb, float* xf) {
    const int tid = tid_opaque(); const int lane = tid & 63, nw = gridDim.x * 8, rpw = (MT + nw - 1) / nw, wv = vblk() * 8 + (tid >> 6);
    float gv[2][8], bv[2][8];
#pragma unroll
    for (int j = 0; j < 2; ++j) { const f32x4 g0 = *(const f32x4*)(g + j * 512 + lane * 8), g1 = *(const f32x4*)(g + j * 512 + lane * 8 + 4), b0 = *(const f32x4*)(b + j * 512 + lane * 8), b1 = *(const f32x4*)(b + j * 512 + lane * 8 + 4);
#pragma unroll
        for (int e = 0; e < 4; ++e) { gv[j][e] = g0[e]; gv[j][4 + e] = g1[e]; bv[j][e] = b0[e]; bv[j][4 + e] = b1[e]; } }
    const int rend = ((wv + 1) * rpw < MT) ? (wv + 1) * rpw : MT;
    for (int rowa = wv * rpw; rowa < rend; rowa += 2) {
        const int rowb = (rowa + 1 < rend) ? rowa + 1 : rowa; const bool hb = rowa + 1 < rend;
        float v[2][2][8];
#pragma unroll
        for (int r = 0; r < 2; ++r)
#pragma unroll
            for (int j = 0; j < 2; ++j) { const u32x4 w = __builtin_nontemporal_load((const u32x4*)(xh + (size_t)(r ? rowb : rowa) * 1024 + j * 512 + lane * 8));
                const f32x2 p0 = unpack_h2(w.x), p1 = unpack_h2(w.y), p2 = unpack_h2(w.z), p3 = unpack_h2(w.w);
                v[r][j][0] = p0.x; v[r][j][1] = p0.y; v[r][j][2] = p1.x; v[r][j][3] = p1.y; v[r][j][4] = p2.x; v[r][j][5] = p2.y; v[r][j][6] = p3.x; v[r][j][7] = p3.y; }
        float s[2] = {0.f, 0.f}, q[2] = {0.f, 0.f};
#pragma unroll
        for (int r = 0; r < 2; ++r)
#pragma unroll
            for (int j = 0; j < 2; ++j)
#pragma unroll
                for (int e = 0; e < 8; ++e) s[r] += v[r][j][e];
#pragma unroll
        for (int o = 32; o >= 1; o >>= 1) { s[0] += __shfl_xor(s[0], o); s[1] += __shfl_xor(s[1], o); }
#pragma unroll
        for (int r = 0; r < 2; ++r) { const float mean = s[r] * (1.0f / 1024.0f);
#pragma unroll
            for (int j = 0; j < 2; ++j)
#pragma unroll
                for (int e = 0; e < 8; ++e) { v[r][j][e] -= mean; q[r] += v[r][j][e] * v[r][j][e]; } }
#pragma unroll
        for (int o = 32; o >= 1; o >>= 1) { q[0] += __shfl_xor(q[0], o); q[1] += __shfl_xor(q[1], o); }
#pragma unroll
        for (int r = 0; r < 2; ++r) { if (r == 1 && !hb) break; const int row = r ? rowb : rowa; const float rstd2 = 1.0f / __builtin_sqrtf(q[r] * (1.0f / 1024.0f) + LN_EPS);
#pragma unroll
            for (int j = 0; j < 2; ++j) { float y[8];
#pragma unroll
                for (int e = 0; e < 8; ++e) y[e] = v[r][j][e] * rstd2 * gv[j][e] + bv[j][e];
                const size_t off = (size_t)row * 1024 + j * 512 + lane * 8;
                if (xb) *(u32x4*)(xb + off) = pack8(y);
                if (xf) { __builtin_nontemporal_store((f32x4){y[0], y[1], y[2], y[3]}, (f32x4*)(xf + off)); __builtin_nontemporal_store((f32x4){y[4], y[5], y[6], y[7]}, (f32x4*)(xf + off + 4)); } } }
    }
}


#define XB_TMO      128
#define XB_XCNT(j)  (256  + 64 * (j))
#define XB_XSUB(j)  (1280 + 64 * (j))
#define XB_XGEN(j)  (2304 + 64 * (j))
#define XB_TOP      3328
#define XB_TOPGEN   3392
#define XCD_BAR_WORDS 3456
#define XB_SPIN_CAP (1u << 18)
__device__ __forceinline__ unsigned xb_ld(unsigned* p)              { return __hip_atomic_load(p, __ATOMIC_RELAXED, __HIP_MEMORY_SCOPE_AGENT); }
__device__ __forceinline__ unsigned xb_add(unsigned* p, unsigned v) { return __hip_atomic_fetch_add(p, v, __ATOMIC_RELAXED, __HIP_MEMORY_SCOPE_AGENT); }
__device__ __forceinline__ unsigned xb_xcc_id() { return (unsigned)__builtin_amdgcn_s_getreg((3 << 11) | 20) & 0xFu; }
#define XB_SPIN(cond, bar) do { unsigned _sp = 0; while (cond) { __builtin_amdgcn_s_sleep(1); \
    if ((++_sp & 255u) == 0u) { if (xb_ld(&(bar)[XB_TMO])) break; if (_sp > XB_SPIN_CAP) { atomicAdd(&(bar)[XB_TMO], 1u); break; } } } } while (0)
struct XcdBarrier { unsigned* bar; unsigned x; volatile LAS unsigned* st; };
__device__ __forceinline__ XcdBarrier xcd_barrier_post(unsigned* bar, volatile LAS unsigned* st) {
    XcdBarrier b; b.bar = bar; b.x = xb_xcc_id(); b.st = st;
    if (threadIdx.x == 0) (void)xb_add(&bar[XB_XCNT(b.x)], 1u);
    return b;
}
__device__ __forceinline__ void xcd_barrier_complete(unsigned* bar, unsigned x, unsigned& nloc, unsigned& nx) {
    const unsigned G = gridDim.x * gridDim.y * gridDim.z;
    unsigned sum, cnt, mine, sp = 0u;
    for (;;) {
        sum = 0u; cnt = 0u; mine = 0u;
#pragma unroll
        for (unsigned j = 0; j < 16; ++j) { const unsigned c = xb_ld(&bar[XB_XCNT(j)]); sum += c; cnt += (c > 0u) ? 1u : 0u; mine = (j == x) ? c : mine; }
        if (sum == G) break;
        __builtin_amdgcn_s_sleep(1);
        if ((++sp & 255u) == 0u) { if (xb_ld(&bar[XB_TMO])) break; if (sp > XB_SPIN_CAP) { atomicAdd(&bar[XB_TMO], 1u); break; } }
    }
    nloc = mine > 0u ? mine : 1u; nx = cnt > 0u ? cnt : 1u;
}
__device__ __forceinline__ void xcd_barrier(const XcdBarrier& b) {
    asm volatile("s_waitcnt vmcnt(0)" ::: "memory");
    __syncthreads();
    if (threadIdx.x == 0) {
        unsigned* bar = b.bar;
        __builtin_amdgcn_s_waitcnt(0);
        unsigned nloc = b.st[0], nx = b.st[1];
        if (nloc == 0u) { xcd_barrier_complete(bar, b.x, nloc, nx); b.st[0] = nloc; b.st[1] = nx; }
        const unsigned old = xb_add(&bar[XB_XSUB(b.x)], 1u);
        const unsigned gen = old / nloc;
        if (old + 1u == (gen + 1u) * nloc) {
            __builtin_amdgcn_fence(__ATOMIC_RELEASE, "agent");
            asm volatile("s_waitcnt vmcnt(0)" ::: "memory");
            const unsigned og = xb_add(&bar[XB_TOP], 1u);
            const unsigned tg = og / nx;
            if (og + 1u == (tg + 1u) * nx) xb_add(&bar[XB_TOPGEN], 1u);
            else XB_SPIN(xb_ld(&bar[XB_TOPGEN]) == tg, bar);
            __builtin_amdgcn_fence(__ATOMIC_ACQUIRE, "agent");
            xb_add(&bar[XB_XGEN(b.x)], 1u);
            asm volatile("s_waitcnt vmcnt(0)" ::: "memory");
        } else {
            XB_SPIN(xb_ld(&bar[XB_XGEN(b.x)]) == gen, bar);
            __builtin_amdgcn_fence(__ATOMIC_ACQUIRE, "agent");
            asm volatile("s_waitcnt vmcnt(0)" ::: "memory");
        }
    }
    __syncthreads();
}


__device__ __forceinline__ void xb2_barrier(unsigned* bar, unsigned x, unsigned nloc, unsigned nx, unsigned k) {
    asm volatile("s_waitcnt vmcnt(0)" ::: "memory");
    __syncthreads();
    if (threadIdx.x == 0) {
        const unsigned old = xb_add(&bar[XB_XSUB(x)], 1u);
        if (old + 1u == (k + 1u) * nloc) {
            __builtin_amdgcn_fence(__ATOMIC_RELEASE, "agent");
            asm volatile("s_waitcnt vmcnt(0)" ::: "memory");
            (void)xb_add(&bar[XB_TOP], 1u);
        }
        while (xb_ld(&bar[XB_TOP]) < (k + 1u) * nx) __builtin_amdgcn_s_sleep(1);
        __builtin_amdgcn_fence(__ATOMIC_ACQUIRE, "agent");
        asm volatile("s_waitcnt vmcnt(0)" ::: "memory");
    }
    __syncthreads();
}
__global__ void __launch_bounds__(512, 2) fwd_megakernel(Params p) {
    extern __shared__ __attribute__((aligned(16))) unsigned char shm[];
    LAS unsigned char* lds = (LAS unsigned char*)shm;
    cg::grid_group grid = cg::this_grid();
    unsigned char* ws = p.ws; const int G = gridDim.x, c = blockIdx.x;
    const size_t TS = (size_t)256 * 1024 * 2;
    bf16_t* slot0 = (bf16_t*)(ws + WS_SLOT);
#define slot(i) ((bf16_t*)(ws + WS_SLOT + (size_t)(i) * SLOT))
    float* O = p.out; bf16_t* O_lo = (bf16_t*)p.out; bf16_t* O_hi = (bf16_t*)((unsigned char*)p.out + SLOT);

    unsigned* const xbar = (unsigned*)(ws + WS_BAR); unsigned* const xtab = xbar + 4096; const unsigned xcc = xb_xcc_id();
    if (blockIdx.x == 0) for (int i = threadIdx.x; i < XCD_BAR_WORDS; i += 512) __hip_atomic_store(&xbar[i], 0u, __ATOMIC_RELAXED, __HIP_MEMORY_SCOPE_AGENT);
    if (threadIdx.x == 0) __hip_atomic_store(&xtab[blockIdx.x], xcc, __ATOMIC_RELAXED, __HIP_MEMORY_SCOPE_AGENT);
    unsigned xb_nloc = 1u, xb_nx = 1u, xb_k = 0u;
#define GSYNC() do { xb2_barrier(xbar, xcc, xb_nloc, xb_nx, xb_k); ++xb_k; } while (0)
#define WGSYNC() do { asm volatile("s_waitcnt vmcnt(0)" ::: "memory"); __syncthreads(); if (threadIdx.x == 0) { __builtin_amdgcn_fence(__ATOMIC_ACQUIRE, "agent"); asm volatile("s_waitcnt vmcnt(0)" ::: "memory"); } __syncthreads(); } while (0)
    {
    phase_prep(p, lds);
    }
    grid.sync();
    { unsigned mine = 0u, present = 0u; const int lane_ = threadIdx.x & 63;
      for (int base = 0; base < (int)gridDim.x; base += 64) { const int e = base + lane_; const unsigned v = (e < (int)gridDim.x) ? xb_ld(&xtab[e]) : 0xffu;
          mine += (unsigned)__builtin_popcountll(__builtin_amdgcn_ballot_w64(v == xcc));
#pragma unroll
          for (unsigned id = 0; id < 16; ++id) present |= (__builtin_amdgcn_ballot_w64(v == id) != 0ull) ? (1u << id) : 0u; }
      xb_nloc = (unsigned)__builtin_amdgcn_readfirstlane((int)mine); xb_nx = (unsigned)__builtin_amdgcn_readfirstlane((int)__builtin_popcount(present)); }
    {
    { SchedProj S; S.o.init(128, 28, G, c); S.xb = (const char*)O_lo; S.win = (const char*)(ws + WS_WIN); S.memb = (const char*)(ws + WS_MEMB); S.wk = (const char*)(ws + WS_WK); S.wv = (const char*)(ws + WS_WV);
      EpiProj E{slot0, p.in[13], (bf16_t*)(ws + WS_KB), (bf16_t*)(ws + WS_VT)};
      gemm_phase(lds, 1024, 1024, 1024, S, E); }
    }
    GSYNC();
    {
    phase_conv(p);
    { SchedKVS S; S.G = G; S.c = c; S.memb = (const char*)(ws + WS_MEMB); S.wk = (const char*)(ws + WS_WK); S.wv = (const char*)(ws + WS_WV);
      EpiPart E{(float*)slot(4)};
      gemm_phase(lds, 1024, 1024, 256, S, E); }
    }
    GSYNC();
    {
    { SchedG S; S.o.init(128, 8, G, c); S.A = (const char*)O_hi; S.B = (const char*)(ws + WS_WG); S.a_pm = TS; S.a_pn = 512; S.a_sh = 1; S.b_pn = (size_t)256 * 256 * 2; S.b_pb = 0;
      EpiGates E{O_hi, p.in[6], p.in[8], (const float*)(ws + WS_SP), (unsigned short*)slot(1), (unsigned short*)slot(2)};
      gemm_phase(lds, 1024, 256, 256, S, E); }
    { const float* part = (const float*)slot(4); bf16_t* kb = (bf16_t*)(ws + WS_KB); bf16_t* vb = (bf16_t*)(ws + WS_VT);
      for (int i = blockIdx.x * 512 + tid_opaque(); i < 2 * 1024 * 128; i += gridDim.x * 512) { const int mat = i >> 17, e8 = (i & 131071) * 8; const float* q = part + (size_t)mat * 4 * 1024 * 1024 + e8;
          f32x4 a = *(const f32x4*)q, b = *(const f32x4*)(q + 4);
#pragma unroll
          for (int ks = 1; ks < 4; ++ks) { a += *(const f32x4*)(q + (size_t)ks * 1024 * 1024); b += *(const f32x4*)(q + (size_t)ks * 1024 * 1024 + 4); }
          float f[8] = {a[0], a[1], a[2], a[3], b[0], b[1], b[2], b[3]}; *(u32x4*)((mat ? vb : kb) + e8) = pack8(f); } }
    }
    GSYNC();
    {
    phase_scan1(p);
    { SchedPre S; S.G = G; S.c = c; S.kb = (const char*)(ws + WS_KB); S.wq = (const char*)(ws + WS_WQ); S.wxo = (const char*)(ws + WS_WXO); S.vb = (const char*)(ws + WS_VT);
      EpiPre E{(bf16_t*)O_hi, (bf16_t*)O_hi + (size_t)16 * 256 * 1024};
      gemm_phase(lds, 1024, 1024, 256, S, E); }
    }
    GSYNC();
    {
    phase_scan3(p);
    }
    GSYNC();
    {
    { SchedMerge S; S.o.init(128, 4, G, c); S.A1 = (const char*)slot(3); S.B1 = (const char*)(ws + WS_WLRU); S.A2 = (const char*)O_lo; S.B2 = (const char*)(ws + WS_WSC);
      EpiMerge E{slot(5), slot(6), slot(4)};
      gemm_phase(lds, 1024, 1024, 1024, S, E); }
    }
    GSYNC();
    {
    { SchedG S; S.o.init(128, 4, G, c); S.A = (const char*)slot(4); S.B = (const char*)(ws + WS_WMIX); S.a_pm = TS; S.a_pn = 0; S.a_sh = 0; S.b_pn = TS; S.b_pb = 0;
      EpiRes E{p.in[0], (unsigned short*)O};
      gemm_phase(lds, 1024, 1024, 1024, S, E); }
    }
    GSYNC();
    {
    phase_ln((const unsigned short*)O, p.in[15], p.in[16], slot(3), nullptr);
    }
    GSYNC();
    {
    { SchedG S; S.o.init(128, 4, G, c); S.A = (const char*)slot(3); S.B = (const char*)O_hi; S.a_pm = TS; S.a_pn = 0; S.a_sh = 0; S.b_pn = TS; S.b_pb = 4 * TS;
      EpiScoreN E{slot(4)};
      gemm_phase(lds, 1024, 1024, 1024, S, E); }
    }
    GSYNC();
    {
    { SchedG S; S.o.init(128, 4, G, c); S.A = (const char*)slot(4); S.B = (const char*)((bf16_t*)O_hi + (size_t)16 * 256 * 1024); S.a_pm = TS; S.a_pn = 0; S.a_sh = 0; S.b_pn = TS; S.b_pb = 4 * TS;
      EpiResB E{slot(3), (unsigned short*)O};
      gemm_phase(lds, 1024, 1024, 1024, S, E); }
    }
    GSYNC();
    {
    phase_ln((const unsigned short*)O, p.in[21], p.in[22], slot(3), nullptr);
    }
    GSYNC();
    {
    { SchedG S; S.o.init(128, 12, G, c); S.A = (const char*)slot(3); S.B = (const char*)(ws + WS_WFG); S.a_pm = TS; S.a_pn = 0; S.a_sh = 0; S.b_pn = TS; S.b_pb = 0;
      EpiBf16 E{slot(4), DFF, 1.0f};
      gemm_phase(lds, 1024, 1024, 1024, S, E); }
    }
    GSYNC();
    {
    { SchedG S; S.o.init(128, 12, G, c); S.A = (const char*)slot(3); S.B = (const char*)(ws + WS_WFU); S.a_pm = TS; S.a_pn = 0; S.a_sh = 0; S.b_pn = TS; S.b_pb = 0;
      EpiFfnUp E{slot(4), p.in[25], p.in[26], slot(0)};
      gemm_phase(lds, 1024, 1024, 1024, S, E); }
    }
    GSYNC();
    {
    { SchedG S; S.o.init(128, 4, G, c); S.A = (const char*)slot(0); S.B = (const char*)(ws + WS_WFD); S.a_pm = (size_t)256 * DFF * 2; S.a_pn = 0; S.a_sh = 0; S.b_pn = (size_t)256 * DFF * 2; S.b_pb = 0;
      EpiResB E{slot(3), (unsigned short*)slot(4)};
      gemm_phase(lds, DFF, DFF, DFF, S, E); }
    }
    GSYNC();
    {
    phase_ln((const unsigned short*)slot(4), p.in[28], p.in[29], nullptr, O);
    }
}

extern "C" void kernel_launch(void* const* d_in, const int* in_sizes, int n_in, void* d_out, int out_size, void* d_ws, size_t ws_size, hipStream_t stream) {
    static int grid_blocks = 0;
    if (grid_blocks == 0) {
        if (n_in != 30 || out_size != MT * DM || ws_size < WS_END) { fprintf(stderr, "kernel_launch: unexpected shapes (n_in %d out %d ws %zu, need %zu)\n", n_in, out_size, ws_size, (size_t)WS_END); grid_blocks = -1; return; }
        int dev = 0, cus = 0, per_cu = 0;
        (void)hipGetDevice(&dev);
        (void)hipDeviceGetAttribute(&cus, hipDeviceAttributeMultiprocessorCount, dev);
        if (hipFuncSetAttribute((const void*)fwd_megakernel, hipFuncAttributeMaxDynamicSharedMemorySize, LDS_BYTES) != hipSuccess) { fprintf(stderr, "kernel_launch: hipFuncSetAttribute failed\n"); grid_blocks = -1; return; }
        if (hipOccupancyMaxActiveBlocksPerMultiprocessor(&per_cu, (const void*)fwd_megakernel, 512, LDS_BYTES) != hipSuccess || per_cu < 1) { fprintf(stderr, "kernel_launch: occupancy query failed (%d)\n", per_cu); grid_blocks = -1; return; }
        grid_blocks = cus * 1;
    }
    if (grid_blocks < 0) return;
    Params p{};
    for (int i = 0; i < 30; ++i) p.in[i] = (const float*)d_in[i];
    p.out = (float*)d_out; p.ws = (unsigned char*)d_ws;
    void* args[] = {&p};
    hipError_t e = hipLaunchCooperativeKernel((const void*)fwd_megakernel, dim3(grid_blocks), dim3(512), args, LDS_BYTES, stream);
    if (e != hipSuccess) fprintf(stderr, "cooperative launch failed: %s (grid %d)\n", hipGetErrorString(e), grid_blocks);
}
```

```cpp
#include <hip/hip_runtime.h>
#include <hip/hip_cooperative_groups.h>
#include <cstdio>
namespace cg = cooperative_groups;

#define LAS __attribute__((address_space(3)))
typedef unsigned short bf16_t;
typedef short bf16x8 __attribute__((ext_vector_type(8)));
typedef float f32x4 __attribute__((ext_vector_type(4)));
typedef float f32x2 __attribute__((ext_vector_type(2)));
typedef unsigned u32x4 __attribute__((ext_vector_type(4)));
typedef unsigned u32x2 __attribute__((ext_vector_type(2)));
typedef _Float16 h16x2 __attribute__((ext_vector_type(2)));

constexpr int MT = 32768, DM = 1024, SEQ = 8192, NMEM = 256, DFF = 3072;
constexpr float ALPHA = 1.189207115002721f, LN_EPS = 1e-5f;
constexpr size_t MiB = (size_t)1 << 20;
constexpr size_t WS_WIN = 0, WS_WG = 14 * MiB, WS_WLRU = 15 * MiB, WS_WSC = 17 * MiB, WS_WMIX = 19 * MiB, WS_WQ = 21 * MiB, WS_WK = 23 * MiB, WS_WV = 25 * MiB,
                 WS_WXO = 27 * MiB, WS_WFG = 29 * MiB, WS_WFU = 35 * MiB, WS_WFD = 41 * MiB, WS_MEMB = 47 * MiB, WS_KB = 49 * MiB, WS_VT = 51 * MiB, WS_RS = 53 * MiB,
                 WS_AGG = 55 * MiB, WS_SP = 57 * MiB, WS_SLOT = 58 * MiB, SLOT = 64 * MiB, WS_END = WS_SLOT + 7 * SLOT;
constexpr int LDS_STAGE = 131072, LDS_XB = LDS_STAGE + 4096, LDS_BYTES = LDS_STAGE + 8192;
constexpr size_t WS_BAR = WS_SP + 65536;

__device__ __forceinline__ unsigned cvt_pk_bf16(float lo, float hi) { unsigned r; asm volatile("v_cvt_pk_bf16_f32 %0, %1, %2" : "=v"(r) : "v"(lo), "v"(hi)); return r; }
__device__ __forceinline__ float bf_lo(unsigned w) { return __uint_as_float(w << 16); }
__device__ __forceinline__ float bf_hi(unsigned w) { return __uint_as_float(w & 0xffff0000u); }
__device__ __forceinline__ void unpack8(const u32x4 w, float (&f)[8]) { f[0] = bf_lo(w.x); f[1] = bf_hi(w.x); f[2] = bf_lo(w.y); f[3] = bf_hi(w.y); f[4] = bf_lo(w.z); f[5] = bf_hi(w.z); f[6] = bf_lo(w.w); f[7] = bf_hi(w.w); }
__device__ __forceinline__ u32x4 pack8(const float (&f)[8]) { u32x4 w; w.x = cvt_pk_bf16(f[0], f[1]); w.y = cvt_pk_bf16(f[2], f[3]); w.z = cvt_pk_bf16(f[4], f[5]); w.w = cvt_pk_bf16(f[6], f[7]); return w; }
__device__ __forceinline__ float sigmoidf_(float x) { return __builtin_amdgcn_rcpf(1.0f + __builtin_amdgcn_exp2f(-1.4426950408889634f * x)); }
__device__ __forceinline__ float gelu_tanh(float x) { const float z = 1.5957691216057308f * (x + 0.044715f * x * x * x); return x * sigmoidf_(z); }
__device__ __forceinline__ unsigned pack_h2(float a, float b) { h16x2 h; h.x = (_Float16)a; h.y = (_Float16)b; return __builtin_bit_cast(unsigned, h); }
__device__ __forceinline__ f32x2 unpack_h2(unsigned w) { const h16x2 h = __builtin_bit_cast(h16x2, w); return (f32x2){(float)h.x, (float)h.y}; }

__device__ __forceinline__ int tid_opaque() { int t = threadIdx.x; asm volatile("" : "+v"(t)); return t; }

__device__ __forceinline__ int vblk() { const int b = blockIdx.x; return (gridDim.x == 256) ? ((b & 7) * 32 + (b >> 3)) : b; }
__device__ __forceinline__ float bperm_xor(float x, int lane_op, int mask) { return __int_as_float(__builtin_amdgcn_ds_bpermute((lane_op ^ mask) << 2, __float_as_int(x))); }

constexpr int BM = 256, BK = 64, HALF = 128, HTB = HALF * BK * 2;
__device__ __forceinline__ int lds_byte(int r, int c) { const int st = (r >> 4) * 2 + (c >> 5), rr = r & 15, cc = c & 31, ob = rr * 64 + cc * 2; return st * 1024 + (ob ^ (((ob >> 9) & 1) << 5)); }
__device__ __forceinline__ void stage_rc(int b, int& R, int& C) { const int st = b / 1024, sb = b % 1024, swz = sb ^ (((sb >> 9) & 1) << 5); R = (st >> 1) * 16 + swz / 64; C = (st & 1) * 32 + (swz % 64) / 2; }
__device__ __forceinline__ int perm32(int rho) { const int n = rho >> 4, i = rho & 15; return 8 * (i >> 2) + 4 * n + (i & 3); }

struct Unit { int pm, pn, kind; const char* a; const char* b; };

struct TileOrder {
    int nM, nN, nwg, G, c;
    __device__ __forceinline__ void init(int nM_, int nN_, int G_, int c_) { nM = nM_; nN = nN_; nwg = nM_ * nN_; G = G_; c = c_; }
    __device__ __forceinline__ bool map(int L, int& pm, int& pn) const {
        if (L >= nwg) return false;
        int wgid = L; { const int q = nwg / 8, r = nwg % 8, xcd = wgid % 8, off = wgid / 8; wgid = (xcd < r ? xcd * (q + 1) : r * (q + 1) + (xcd - r) * q) + off; }
        const int nig = 8 * nN, gid = wgid / nig, fm = gid * 8, gsz = (nM - fm) < 8 ? (nM - fm) : 8;
        pm = fm + ((wgid % nig) % gsz); pn = (wgid % nig) / gsz; return true;
    }
};
struct SchedG {
    TileOrder o; const char* A; const char* B; size_t a_pm, a_pn; int a_sh; size_t b_pn, b_pb;
    __device__ __forceinline__ bool next(int i, Unit& u) const {
        if (!o.map(i * o.G + o.c, u.pm, u.pn)) return false;
        u.kind = 0; u.a = A + (size_t)u.pm * a_pm + (size_t)(u.pn >> a_sh) * a_pn; u.b = B + (size_t)u.pn * b_pn + (size_t)(u.pm >> 5) * b_pb; return true; }
};
struct SchedMerge {
    TileOrder o; const char* A1; const char* B1; const char* A2; const char* B2;
    __device__ __forceinline__ bool next(int i, Unit& u) const {
        if (!o.map((i >> 1) * o.G + o.c, u.pm, u.pn)) return false;
        u.kind = i & 1; const size_t ts = (size_t)256 * 1024 * 2;
        u.a = (u.kind ? A2 : A1) + (size_t)u.pm * ts; u.b = (u.kind ? B2 : B1) + (size_t)u.pn * ts; return true; }
};
struct SchedProj {
    TileOrder o; const char* xb; const char* win; const char* memb; const char* wk; const char* wv;
    __device__ __forceinline__ bool next(int i, Unit& u) const {
        const int L = i * o.G + o.c; const size_t ts = (size_t)256 * 1024 * 2;
        if (o.map(L, u.pm, u.pn)) { u.kind = 0; u.a = xb + (size_t)u.pm * ts; u.b = win + (size_t)u.pn * ts; return true; }
        const int e = L - o.nwg; if (e >= 0) return false;
        if (e < 16) { u.kind = 1; u.pm = e >> 2; u.pn = e & 3; u.a = memb + (size_t)u.pm * ts; u.b = wk + (size_t)u.pn * ts; }
        else { const int f = e - 16; u.kind = 2; u.pm = f >> 2; u.pn = f & 3; u.a = memb + (size_t)u.pm * ts; u.b = wv + (size_t)u.pn * ts; }
        return true; }
};

typedef f32x4 Acc[2][2][4][2];

template <class Epi, class Sched>
__device__ __forceinline__ void gemm_phase(LAS unsigned char* lds, const int lda, const int ldb, const int K, const Sched& S, const Epi& E) {
    int tid_ = threadIdx.x; asm volatile("" : "+v"(tid_));
    const int tid = tid_, wid = __builtin_amdgcn_readfirstlane(tid >> 6), lane = tid & 63, wr = wid >> 2, wc = wid & 3, fr = lane & 15, fq = lane >> 4;
    const int nt = K / BK;
    unsigned voffA[2], voffB[2];
#pragma unroll
    for (int i = 0; i < 2; ++i) { int R, C; stage_rc(tid * 16 + i * 8192, R, C); const int Rb = (R & ~31) + perm32(R & 31);
        voffA[i] = (unsigned)(R * lda + C) * 2u; voffB[i] = (unsigned)(Rb * ldb + C) * 2u; }
    const size_t kstep = (size_t)(BK * 2);
    const size_t hstepA = (size_t)HALF * lda * 2, hstepB = (size_t)HALF * ldb * 2;
    const unsigned ldsw = (unsigned)wid * 1024u;
    const int aoff = lds_byte(wr * 64 + fr, fq * 8), boff = lds_byte(wc * 32 + fr, fq * 8);
    LAS unsigned char* xl = lds + LDS_STAGE;
#define PG8_SA(b, h) (((b) * 2 + (h)) * HTB)
#define PG8_SB(b, h) ((4 + (b) * 2 + (h)) * HTB)
#define PG8_STAGE(bufoff, gbase, voff) do { _Pragma("unroll") for (int _i = 0; _i < 2; ++_i) \
        __builtin_amdgcn_global_load_lds((const unsigned*)((const char*)(gbase) + (voff)[_i]), (LAS unsigned*)(lds + (bufoff) + ldsw + _i * 8192), 16, 0, 0); } while (0)
#define PG8_LDA(dst, b, h) do { _Pragma("unroll") for (int m = 0; m < 4; ++m) _Pragma("unroll") for (int k = 0; k < 2; ++k) dst[m][k] = *(const LAS bf16x8*)(lds + PG8_SA(b, h) + aoff + m * 2048 + k * 1024); } while (0)
#define PG8_LDB(dst, b, h) do { _Pragma("unroll") for (int n = 0; n < 2; ++n) _Pragma("unroll") for (int k = 0; k < 2; ++k) dst[n][k] = *(const LAS bf16x8*)(lds + PG8_SB(b, h) + boff + n * 2048 + k * 1024); } while (0)
#define PG8_MMA(ai, bj, At, Bt) do { __builtin_amdgcn_s_setprio(1); _Pragma("unroll") for (int m = 0; m < 4; ++m) _Pragma("unroll") for (int n = 0; n < 2; ++n) _Pragma("unroll") for (int k = 0; k < 2; ++k) \
        acc[ai][bj][m][n] = __builtin_amdgcn_mfma_f32_16x16x32_bf16(Bt[n][k], At[m][k], acc[ai][bj][m][n], 0, 0, 0); __builtin_amdgcn_s_setprio(0); } while (0)
#define PG8_WAIT_V(n) asm volatile("s_waitcnt vmcnt(" #n ")" ::: "memory")
#define PG8_WAIT_L(n) asm volatile("s_waitcnt lgkmcnt(" #n ")" ::: "memory")
#define PG8_BAR __builtin_amdgcn_s_barrier()
#define PG8_SCHED __builtin_amdgcn_sched_barrier(0)
    Unit cur, nxt; int ui = 0;
    if (!S.next(0, cur)) return;
    Acc acc;
#pragma unroll
    for (int a = 0; a < 2; ++a)
#pragma unroll
        for (int b = 0; b < 2; ++b)
#pragma unroll
            for (int m = 0; m < 4; ++m)
#pragma unroll
                for (int n = 0; n < 2; ++n) acc[a][b][m][n] = (f32x4){0.f, 0.f, 0.f, 0.f};
    bf16x8 At[4][2], B0[2][2], B1[2][2];
    const char* cA = cur.a; const char* cB = cur.b;
    PG8_STAGE(PG8_SB(0, 0), cB, voffB); PG8_STAGE(PG8_SB(0, 1), cB + hstepB, voffB); PG8_STAGE(PG8_SA(0, 0), cA, voffA); PG8_STAGE(PG8_SA(0, 1), cA + hstepA, voffA);
    if (wr == 1) PG8_BAR;
    PG8_WAIT_V(2); PG8_BAR;
    PG8_STAGE(PG8_SB(1, 0), cB + kstep, voffB); PG8_STAGE(PG8_SA(1, 0), cA + kstep, voffA); PG8_STAGE(PG8_SB(1, 1), cB + hstepB + kstep, voffB);
    PG8_WAIT_V(6); PG8_BAR;
    for (;;) {
        const bool has_next = S.next(ui + 1, nxt);
        const char* nA = has_next ? nxt.a : cA; const char* nB = has_next ? nxt.b : cB;
#pragma unroll 1
        for (int t = 0; t < nt; t += 2) {
            const bool last = (t == nt - 2);
            const char* a1 = cA + (size_t)(t + 1) * kstep;
            const char* a2 = last ? nA : cA + (size_t)(t + 2) * kstep; const char* b2 = last ? nB : cB + (size_t)(t + 2) * kstep;
            const char* a3 = a2 + kstep; const char* b3 = b2 + kstep;
            PG8_LDB(B0, 0, 0); PG8_LDB(B1, 0, 1); PG8_SCHED; PG8_LDA(At, 0, 0); PG8_STAGE(PG8_SA(1, 1), a1 + hstepA, voffA);
            PG8_WAIT_V(8); PG8_WAIT_L(0); PG8_BAR; PG8_MMA(0, 0, At, B0); PG8_MMA(0, 1, At, B1); PG8_BAR; PG8_SCHED;
            PG8_LDA(At, 0, 1); PG8_STAGE(PG8_SB(0, 0), b2, voffB); PG8_STAGE(PG8_SB(0, 1), b2 + hstepB, voffB); PG8_STAGE(PG8_SA(0, 0), a2, voffA);
            PG8_WAIT_V(8); PG8_WAIT_L(0); PG8_BAR; PG8_MMA(1, 0, At, B0); PG8_MMA(1, 1, At, B1); PG8_BAR; PG8_SCHED;
            PG8_LDB(B0, 1, 0); PG8_LDB(B1, 1, 1); PG8_SCHED; PG8_LDA(At, 1, 0); PG8_STAGE(PG8_SA(0, 1), a2 + hstepA, voffA);
            PG8_WAIT_V(8); PG8_WAIT_L(0); PG8_BAR; PG8_MMA(0, 0, At, B0); PG8_MMA(0, 1, At, B1); PG8_BAR; PG8_SCHED;
            PG8_LDA(At, 1, 1); PG8_STAGE(PG8_SB(1, 0), b3, voffB); PG8_STAGE(PG8_SB(1, 1), b3 + hstepB, voffB); PG8_STAGE(PG8_SA(1, 0), a3, voffA);
            PG8_WAIT_V(8); PG8_WAIT_L(0); PG8_BAR; PG8_MMA(1, 0, At, B0); PG8_MMA(1, 1, At, B1); PG8_BAR; PG8_SCHED;
        }
        if (wr == 0) PG8_BAR;
        const bool keep = E(acc, cur, wr, wc, fr, fq, xl);
        if (!has_next) break;
        if (!keep) {
#pragma unroll
            for (int a = 0; a < 2; ++a)
#pragma unroll
                for (int b = 0; b < 2; ++b)
#pragma unroll
                    for (int m = 0; m < 4; ++m)
#pragma unroll
                        for (int n = 0; n < 2; ++n) acc[a][b][m][n] = (f32x4){0.f, 0.f, 0.f, 0.f};
        }
        cur = nxt; cA = nA; cB = nB; ++ui;
        if (wr == 1) PG8_BAR;
    }
    PG8_WAIT_V(0);
    PG8_BAR;
#undef PG8_SA
#undef PG8_SB
#undef PG8_STAGE
#undef PG8_LDA
#undef PG8_LDB
#undef PG8_MMA
#undef PG8_WAIT_V
#undef PG8_WAIT_L
#undef PG8_BAR
#undef PG8_SCHED
}

#define EPI_GEOM int lo; asm volatile("v_mbcnt_lo_u32_b32 %0, -1, 0\n\tv_mbcnt_hi_u32_b32 %0, -1, %0" : "=v"(lo)); (void)fr; (void)fq; \
    const int fr_ = lo & 15, fq_ = lo >> 4; const int row0 = u.pm * 256 + wr * 64 + fr_, colw = wc * 32 + 8 * fq_
#define ACC8(v, ai, bj, m) float v[8] = {acc[ai][bj][m][0][0], acc[ai][bj][m][0][1], acc[ai][bj][m][0][2], acc[ai][bj][m][0][3], acc[ai][bj][m][1][0], acc[ai][bj][m][1][1], acc[ai][bj][m][1][2], acc[ai][bj][m][1][3]}

struct EpiProj {
    bf16_t* slots; const float* bmerge; bf16_t* kb; bf16_t* vt;
    __device__ __forceinline__ bool operator()(Acc& acc, const Unit& u, int wr, int wc, int fr, int fq, LAS unsigned char*) const {
        EPI_GEOM;
        bf16_t* base; int ldc, act = 0; const float* bias = nullptr;
        if (u.kind == 0) { const int seg = u.pn >> 2; base = slots + (size_t)seg * (SLOT / 2) + (u.pn & 3) * 256; ldc = 1024;
            act = (seg == 0) ? 1 : (seg >= 5 ? 2 : 0); if (seg >= 5) bias = bmerge + (seg - 5) * 1024 + (u.pn & 3) * 256; }
        else if (u.kind == 1) { base = kb + u.pn * 256; ldc = 1024; }
        else { base = vt + u.pn * 256; ldc = 1024; }
        if (u.kind == 0 && u.pn >= 12 && u.pn < 20) {
            bf16_t* pb = slots + (size_t)3 * (SLOT / 2) + (u.pn - 12) * 128 + colw;
#pragma unroll
            for (int ai = 0; ai < 2; ++ai)
#pragma unroll
                for (int m = 0; m < 4; ++m) { ACC8(vc, ai, 0, m); ACC8(vh, ai, 1, m);
#pragma unroll
                    for (int j = 0; j < 8; ++j) vc[j] *= vh[j];
                    *(u32x4*)(pb + (size_t)(row0 + ai * 128 + m * 16) * 1024) = pack8(vc); }
            return false;
        }
#pragma unroll
        for (int bj = 0; bj < 2; ++bj) {
            float bv[8];
#pragma unroll
            for (int j = 0; j < 8; ++j) bv[j] = 0.f;
            if (act == 2) { const f32x4 b0 = *(const f32x4*)(bias + colw + bj * 128), b1 = *(const f32x4*)(bias + colw + bj * 128 + 4);
#pragma unroll
                for (int j = 0; j < 4; ++j) { bv[j] = b0[j]; bv[4 + j] = b1[j]; } }
#pragma unroll
            for (int ai = 0; ai < 2; ++ai)
#pragma unroll
                for (int m = 0; m < 4; ++m) { ACC8(v, ai, bj, m);
                    if (act == 1) {
#pragma unroll
                        for (int j = 0; j < 8; ++j) v[j] = gelu_tanh(v[j]); }
                    else if (act == 2) {
#pragma unroll
                        for (int j = 0; j < 8; ++j) v[j] = sigmoidf_(v[j] + bv[j]); }
                    *(u32x4*)(base + (size_t)(row0 + ai * 128 + m * 16) * ldc + colw + bj * 128) = pack8(v); }
        }
        return false;
    }
};
struct EpiBf16 {
    bf16_t* out; int ldc; float scale;
    __device__ __forceinline__ bool operator()(Acc& acc, const Unit& u, int wr, int wc, int fr, int fq, LAS unsigned char*) const {
        EPI_GEOM;
#pragma unroll
        for (int ai = 0; ai < 2; ++ai)
#pragma unroll
            for (int m = 0; m < 4; ++m)
#pragma unroll
                for (int bj = 0; bj < 2; ++bj) { ACC8(v, ai, bj, m);
#pragma unroll
                    for (int j = 0; j < 8; ++j) v[j] *= scale;
                    *(u32x4*)(out + (size_t)(row0 + ai * 128 + m * 16) * ldc + u.pn * 256 + colw + bj * 128) = pack8(v); }
        return false;
    }
};
struct EpiGates {
    const bf16_t* ub; const float* br; const float* bi; const float* sp; unsigned short* la; unsigned short* bt;
    __device__ __forceinline__ bool operator()(Acc& acc, const Unit& u, int wr, int wc, int fr, int fq, LAS unsigned char*) const {
        EPI_GEOM;
#pragma unroll
        for (int n = 0; n < 2; ++n) { const int ch = u.pn * 128 + colw + 4 * n;
            const f32x4 vbr = *(const f32x4*)(br + ch), vbi = *(const f32x4*)(bi + ch), vsp = *(const f32x4*)(sp + ch);
            u32x2 uws[2][4];
#pragma unroll
            for (int ai = 0; ai < 2; ++ai)
#pragma unroll
                for (int m = 0; m < 4; ++m) uws[ai][m] = *(const u32x2*)(ub + (size_t)(row0 + ai * 128 + m * 16) * 1024 + ch);
#pragma unroll
            for (int ai = 0; ai < 2; ++ai)
#pragma unroll
                for (int m = 0; m < 4; ++m) { const int row = row0 + ai * 128 + m * 16; const bool first = (row & (SEQ - 1)) == 0;
                    const u32x2 uw = uws[ai][m]; const float uu[4] = {bf_lo(uw.x), bf_hi(uw.x), bf_lo(uw.y), bf_hi(uw.y)};
                    float l[4], b[4];
                    float yy[4], ig4[4];
#pragma unroll
                    for (int j = 0; j < 4; ++j) {
                        const float ea = __builtin_amdgcn_exp2f(fminf(-1.4426950408889634f * (acc[ai][0][m][n][j] + vbr[j]), 60.f)), eb = __builtin_amdgcn_exp2f(fminf(-1.4426950408889634f * (acc[ai][1][m][n][j] + vbi[j]), 60.f));
                        const float da = 1.0f + ea, db = 1.0f + eb, rr = __builtin_amdgcn_rcpf(da * db); const float r = rr * db; ig4[j] = rr * da; l[j] = vsp[j] * r; yy[j] = 2.0f * l[j]; }
                    const bool small = __builtin_amdgcn_ballot_w64(fminf(fminf(yy[0], yy[1]), fminf(yy[2], yy[3])) < -0.25f) == 0ull;
#pragma unroll
                    for (int j = 0; j < 4; ++j) { const float y = yy[j];
                        const float em = small ? -y * (1.0f + y * (0.5f + y * (0.16666667f + y * (0.041666668f + y * (0.0083333338f + y * (0.0013888889f + y * 0.0001984127f)))))) : 1.0f - __builtin_amdgcn_exp2f(1.4426950408889634f * y);
                        const float mult = first ? 1.0f : __builtin_amdgcn_sqrtf(em); b[j] = mult * ig4[j] * uu[j]; }
                    u32x2 wl, wb; wl.x = pack_h2(l[0], l[1]); wl.y = pack_h2(l[2], l[3]); wb.x = pack_h2(b[0], b[1]); wb.y = pack_h2(b[2], b[3]);
                    *(u32x2*)(la + (size_t)row * 1024 + ch) = wl; *(u32x2*)(bt + (size_t)row * 1024 + ch) = wb;
                    asm volatile("" ::: "memory"); }
        }
        return false;
    }
};
struct EpiMerge {
    const bf16_t* g1; const bf16_t* g2; bf16_t* out;
    __device__ __forceinline__ bool operator()(Acc& acc, const Unit& u, int wr, int wc, int fr, int fq, LAS unsigned char*) const {
        EPI_GEOM;
#pragma unroll
        for (int ai = 0; ai < 2; ++ai)
#pragma unroll
            for (int m = 0; m < 4; ++m)
#pragma unroll
                for (int bj = 0; bj < 2; ++bj) { const size_t off = (size_t)(row0 + ai * 128 + m * 16) * 1024 + u.pn * 256 + colw + bj * 128;
                    float b[8]; unpack8(*(const u32x4*)(g2 + off), b);
                    if (u.kind == 0) { float a[8]; unpack8(*(const u32x4*)(g1 + off), a);
#pragma unroll
                        for (int j = 0; j < 4; ++j) { acc[ai][bj][m][0][j] *= a[j] * __builtin_amdgcn_rcpf(b[j]); acc[ai][bj][m][1][j] *= a[4 + j] * __builtin_amdgcn_rcpf(b[4 + j]); } }
                    else { ACC8(v, ai, bj, m);
#pragma unroll
                        for (int j = 0; j < 8; ++j) v[j] *= b[j];
                        *(u32x4*)(out + off) = pack8(v); } }
        return u.kind == 0;
    }
};
struct EpiRes {
    const float* res; unsigned short* outh;
    __device__ __forceinline__ bool operator()(Acc& acc, const Unit& u, int wr, int wc, int fr, int fq, LAS unsigned char*) const {
        EPI_GEOM;
#pragma unroll
        for (int ai = 0; ai < 2; ++ai)
#pragma unroll
            for (int bj = 0; bj < 2; ++bj) { const size_t off0 = (size_t)(row0 + ai * 128) * 1024 + u.pn * 256 + colw + bj * 128;
                f32x4 r0[4], r1[4];
#pragma unroll
                for (int m = 0; m < 4; ++m) { r0[m] = *(const f32x4*)(res + off0 + (size_t)m * 16 * 1024); r1[m] = *(const f32x4*)(res + off0 + (size_t)m * 16 * 1024 + 4); }
#pragma unroll
                for (int m = 0; m < 4; ++m) { const f32x4 t0 = r0[m] * ALPHA + acc[ai][bj][m][0], t1 = r1[m] * ALPHA + acc[ai][bj][m][1];
                    u32x4 w; w.x = pack_h2(t0[0], t0[1]); w.y = pack_h2(t0[2], t0[3]); w.z = pack_h2(t1[0], t1[1]); w.w = pack_h2(t1[2], t1[3]);
                    *(u32x4*)(outh + off0 + (size_t)m * 16 * 1024) = w; }
                asm volatile("" ::: "memory"); }
        return false;
    }
};
struct EpiResB {
    const bf16_t* resb; unsigned short* outh;
    __device__ __forceinline__ bool operator()(Acc& acc, const Unit& u, int wr, int wc, int fr, int fq, LAS unsigned char*) const {
        EPI_GEOM;
#pragma unroll
        for (int ai = 0; ai < 2; ++ai) { const size_t off0 = (size_t)(row0 + ai * 128) * 1024 + u.pn * 256 + colw;
            u32x4 rb[4][2];
#pragma unroll
            for (int m = 0; m < 4; ++m)
#pragma unroll
                for (int bj = 0; bj < 2; ++bj) rb[m][bj] = *(const u32x4*)(resb + off0 + (size_t)m * 16 * 1024 + bj * 128);
#pragma unroll
            for (int m = 0; m < 4; ++m)
#pragma unroll
                for (int bj = 0; bj < 2; ++bj) { float r[8]; unpack8(rb[m][bj], r);
                    const f32x4 t0 = (f32x4){r[0], r[1], r[2], r[3]} * ALPHA + acc[ai][bj][m][0], t1 = (f32x4){r[4], r[5], r[6], r[7]} * ALPHA + acc[ai][bj][m][1];
                    u32x4 w; w.x = pack_h2(t0[0], t0[1]); w.y = pack_h2(t0[2], t0[3]); w.z = pack_h2(t1[0], t1[1]); w.w = pack_h2(t1[2], t1[3]);
                    *(u32x4*)(outh + off0 + (size_t)m * 16 * 1024 + bj * 128) = w; }
            asm volatile("" ::: "memory"); }
        return false;
    }
};
struct EpiScore {
    bf16_t* P; float* rs;
    __device__ __forceinline__ bool operator()(Acc& acc, const Unit& u, int wr, int wc, int fr, int fq, LAS unsigned char* xl) const {
        EPI_GEOM; LAS float* mx = (LAS float*)xl;
#pragma unroll
        for (int ai = 0; ai < 2; ++ai)
#pragma unroll
            for (int m = 0; m < 4; ++m) { float mv = -3.0e38f;
#pragma unroll
                for (int bj = 0; bj < 2; ++bj)
#pragma unroll
                    for (int n = 0; n < 2; ++n)
#pragma unroll
                        for (int j = 0; j < 4; ++j) mv = fmaxf(mv, acc[ai][bj][m][n][j]);
                mv = fmaxf(mv, bperm_xor(mv, lo, 16)); mv = fmaxf(mv, bperm_xor(mv, lo, 32));
                if (fq_ == 0) mx[(ai * 128 + wr * 64 + m * 16 + fr_) * 4 + wc] = mv; }
        asm volatile("s_waitcnt lgkmcnt(0)" ::: "memory"); __builtin_amdgcn_s_barrier(); asm volatile("" ::: "memory");
#pragma unroll
        for (int ai = 0; ai < 2; ++ai)
#pragma unroll
            for (int m = 0; m < 4; ++m) { const int rl = ai * 128 + wr * 64 + m * 16 + fr_; const f32x4 q = *(const LAS f32x4*)(mx + rl * 4);
                const float mv = fmaxf(fmaxf(q[0], q[1]), fmaxf(q[2], q[3])) * 1.4426950408889634f; float sum = 0.f;
#pragma unroll
                for (int bj = 0; bj < 2; ++bj) { ACC8(v, ai, bj, m);
#pragma unroll
                    for (int j = 0; j < 8; ++j) v[j] = __builtin_amdgcn_exp2f(v[j] * 1.4426950408889634f - mv);
                    const u32x4 w = pack8(v); float r[8]; unpack8(w, r);
#pragma unroll
                    for (int j = 0; j < 8; ++j) sum += r[j];
                    *(u32x4*)(P + (size_t)(row0 + ai * 128 + m * 16) * 1024 + u.pn * 256 + colw + bj * 128) = w; }
                sum += bperm_xor(sum, lo, 16); sum += bperm_xor(sum, lo, 32);
                if (fq_ == 0) rs[((size_t)u.pn * MT + (row0 + ai * 128 + m * 16)) * 4 + wc] = sum;
                asm volatile("" ::: "memory"); }
        return false;
    }
};

struct SchedPre {
    int G, c; const char* kb; const char* wq; const char* wxo; const char* vb;
    __device__ __forceinline__ bool next(int i, Unit& u) const {
        const int L = i * G + c; if (L >= 128) return false;
        const int t = L & 63, b = t >> 4, h = (t >> 2) & 3, nt = t & 3; const size_t ts = (size_t)256 * 1024 * 2;
        u.kind = L >> 6; u.pm = (b << 2) | h; u.pn = nt;
        if (u.kind == 0) { u.a = kb + (size_t)b * ts + h * 512; u.b = wq + (size_t)nt * ts + h * 512; }
        else { u.a = wxo + (size_t)nt * ts + h * 512; u.b = vb + (size_t)b * ts + h * 512; }
        return true; }
};
struct EpiPre {
    bf16_t* gb; bf16_t* vwb;
    __device__ __forceinline__ bool operator()(Acc& acc, const Unit& u, int wr, int wc, int fr, int fq, LAS unsigned char*) const {
        EPI_GEOM; const int b = u.pm >> 2, h = u.pm & 3;
        bf16_t* base = (u.kind == 0) ? gb + (size_t)u.pm * 256 * 1024 + u.pn * 256 : vwb + (size_t)b * 1024 * 1024 + (size_t)u.pn * 256 * 1024 + h * 256;
        const float scale = (u.kind == 0) ? 0.0625f : 1.0f; const int rl0 = wr * 64 + fr_;
#pragma unroll
        for (int ai = 0; ai < 2; ++ai)
#pragma unroll
            for (int m = 0; m < 4; ++m)
#pragma unroll
                for (int bj = 0; bj < 2; ++bj) { ACC8(v, ai, bj, m);
#pragma unroll
                    for (int j = 0; j < 8; ++j) v[j] *= scale;
                    *(u32x4*)(base + (size_t)(rl0 + ai * 128 + m * 16) * 1024 + colw + bj * 128) = pack8(v); }
        (void)row0;
        return false;
    }
};
struct EpiScoreN {
    bf16_t* P;
    __device__ __forceinline__ bool operator()(Acc& acc, const Unit& u, int wr, int wc, int fr, int fq, LAS unsigned char* xl) const {
        EPI_GEOM; LAS float* mx = (LAS float*)xl; LAS float* sx = (LAS float*)(xl + 4096);
#pragma unroll
        for (int ai = 0; ai < 2; ++ai)
#pragma unroll
            for (int m = 0; m < 4; ++m) { float mv = -3.0e38f;
#pragma unroll
                for (int bj = 0; bj < 2; ++bj)
#pragma unroll
                    for (int n = 0; n < 2; ++n)
#pragma unroll
                        for (int j = 0; j < 4; ++j) mv = fmaxf(mv, acc[ai][bj][m][n][j]);
                mv = fmaxf(mv, bperm_xor(mv, lo, 16)); mv = fmaxf(mv, bperm_xor(mv, lo, 32));
                if (fq_ == 0) mx[(ai * 128 + wr * 64 + m * 16 + fr_) * 4 + wc] = mv; }
        asm volatile("s_waitcnt lgkmcnt(0)" ::: "memory"); __builtin_amdgcn_s_barrier(); asm volatile("" ::: "memory");
#pragma unroll
        for (int ai = 0; ai < 2; ++ai)
#pragma unroll
            for (int m = 0; m < 4; ++m) { const int rl = ai * 128 + wr * 64 + m * 16 + fr_; const f32x4 q = *(const LAS f32x4*)(mx + rl * 4);
                const float mv = fmaxf(fmaxf(q[0], q[1]), fmaxf(q[2], q[3])) * 1.4426950408889634f; float sum = 0.f;
#pragma unroll
                for (int bj = 0; bj < 2; ++bj)
#pragma unroll
                    for (int n = 0; n < 2; ++n)
#pragma unroll
                        for (int j = 0; j < 4; ++j) { const float e = __builtin_amdgcn_exp2f(acc[ai][bj][m][n][j] * 1.4426950408889634f - mv); acc[ai][bj][m][n][j] = e; sum += e; }
                sum += bperm_xor(sum, lo, 16); sum += bperm_xor(sum, lo, 32);
                if (fq_ == 0) sx[rl * 4 + wc] = sum; }
        asm volatile("s_waitcnt lgkmcnt(0)" ::: "memory"); __builtin_amdgcn_s_barrier(); asm volatile("" ::: "memory");
#pragma unroll
        for (int ai = 0; ai < 2; ++ai)
#pragma unroll
            for (int m = 0; m < 4; ++m) { const int rl = ai * 128 + wr * 64 + m * 16 + fr_; const f32x4 q = *(const LAS f32x4*)(sx + rl * 4);
                const float inv = __builtin_amdgcn_rcpf((q[0] + q[1]) + (q[2] + q[3]));
#pragma unroll
                for (int bj = 0; bj < 2; ++bj) { ACC8(v, ai, bj, m);
#pragma unroll
                    for (int j = 0; j < 8; ++j) v[j] *= inv;
                    *(u32x4*)(P + (size_t)(row0 + ai * 128 + m * 16) * 1024 + u.pn * 256 + colw + bj * 128) = pack8(v); }
                asm volatile("" ::: "memory"); }
        return false;
    }
};

struct SchedKVS {
    int G, c; const char* memb; const char* wk; const char* wv;
    __device__ __forceinline__ bool next(int i, Unit& u) const {
        const int L = i * G + c; if (L >= 128) return false;
        const int mat = L >> 6, rt = (L >> 4) & 3, ct = (L >> 2) & 3, ks = L & 3; const size_t ts = (size_t)256 * 1024 * 2;
        u.kind = mat * 4 + ks; u.pm = rt; u.pn = ct; u.a = memb + (size_t)rt * ts + ks * 512; u.b = (mat ? wv : wk) + (size_t)ct * ts + ks * 512; return true; }
};
struct EpiPart {
    float* part;
    __device__ __forceinline__ bool operator()(Acc& acc, const Unit& u, int wr, int wc, int fr, int fq, LAS unsigned char*) const {
        EPI_GEOM; float* base = part + (size_t)u.kind * 1024 * 1024;
#pragma unroll
        for (int ai = 0; ai < 2; ++ai)
#pragma unroll
            for (int m = 0; m < 4; ++m)
#pragma unroll
                for (int bj = 0; bj < 2; ++bj) { float* q = base + (size_t)(row0 + ai * 128 + m * 16) * 1024 + u.pn * 256 + colw + bj * 128;
                    *(f32x4*)q = acc[ai][bj][m][0]; *(f32x4*)(q + 4) = acc[ai][bj][m][1]; }
        return false;
    }
};
struct EpiPV {
    const float* rs; bf16_t* out;
    __device__ __forceinline__ bool operator()(Acc& acc, const Unit& u, int wr, int wc, int fr, int fq, LAS unsigned char*) const {
        EPI_GEOM;
#pragma unroll
        for (int ai = 0; ai < 2; ++ai)
#pragma unroll
            for (int m = 0; m < 4; ++m) { const int row = row0 + ai * 128 + m * 16; const f32x4 q = *(const f32x4*)(rs + ((size_t)u.pn * MT + row) * 4);
                const float inv = 1.0f / ((q[0] + q[1]) + (q[2] + q[3]));
#pragma unroll
                for (int bj = 0; bj < 2; ++bj) { ACC8(v, ai, bj, m);
#pragma unroll
                    for (int j = 0; j < 8; ++j) v[j] *= inv;
                    *(u32x4*)(out + (size_t)row * 1024 + u.pn * 256 + colw + bj * 128) = pack8(v); } }
        return false;
    }
};
__device__ __forceinline__ unsigned ror_row(unsigned v, const int n) { return (unsigned)(n == 1 ? __builtin_amdgcn_update_dpp(0, (int)v, 0x121, 0xf, 0xf, false) : __builtin_amdgcn_update_dpp(0, (int)v, 0x122, 0xf, 0xf, false)); }
struct EpiFfnUp {
    const bf16_t* g; const float* cw; const float* cb; bf16_t* out;
    __device__ __forceinline__ bool operator()(Acc& acc, const Unit& u, int wr, int wc, int fr, int fq, LAS unsigned char*) const {
        EPI_GEOM;
#pragma unroll
        for (int bj = 0; bj < 2; ++bj) { const int col = u.pn * 256 + colw + bj * 128;
            float w0[8], w1[8], w2[8], bb[8];
            { const f32x4 a0 = *(const f32x4*)(cw + col), a1 = *(const f32x4*)(cw + col + 4), b0 = *(const f32x4*)(cw + DFF + col), b1 = *(const f32x4*)(cw + DFF + col + 4),
                          c0 = *(const f32x4*)(cw + 2 * DFF + col), c1 = *(const f32x4*)(cw + 2 * DFF + col + 4), d0 = *(const f32x4*)(cb + col), d1 = *(const f32x4*)(cb + col + 4);
#pragma unroll
              for (int j = 0; j < 4; ++j) { w0[j] = a0[j]; w0[4 + j] = a1[j]; w1[j] = b0[j]; w1[4 + j] = b1[j]; w2[j] = c0[j]; w2[4 + j] = c1[j]; bb[j] = d0[j]; bb[4 + j] = d1[j]; } }
#pragma unroll
            for (int ai = 0; ai < 2; ++ai) { const int R = u.pm * 256 + ai * 128 + wr * 64;
                u32x4 G0[4], H1 = (u32x4){0u, 0u, 0u, 0u}, H2 = (u32x4){0u, 0u, 0u, 0u};
#pragma unroll
                for (int m = 0; m < 4; ++m) G0[m] = *(const u32x4*)(g + (size_t)(R + m * 16 + fr_) * DFF + col);
                if ((R & (SEQ - 1)) != 0) { H1 = *(const u32x4*)(g + (size_t)(R - 1) * DFF + col); H2 = *(const u32x4*)(g + (size_t)(R - 2) * DFF + col); }
                u32x4 prev;
#pragma unroll
                for (int j = 0; j < 4; ++j) prev[j] = (fr_ == 15) ? H1[j] : H2[j];
#pragma unroll
                for (int m = 0; m < 4; ++m) { const int row = row0 + ai * 128 + m * 16; const u32x4 cur = G0[m]; u32x4 t1, t2;
#pragma unroll
                    for (int j = 0; j < 4; ++j) { const unsigned c1r = ror_row(cur[j], 1), p1r = ror_row(prev[j], 1), c2r = ror_row(cur[j], 2), p2r = ror_row(prev[j], 2);
                        t1[j] = (fr_ == 0) ? p1r : c1r; t2[j] = (fr_ < 2) ? p2r : c2r; }
                    float g0[8], g1[8], g2[8]; unpack8(cur, g0); unpack8(t1, g1); unpack8(t2, g2);
                    ACC8(v, ai, bj, m);
#pragma unroll
                    for (int j = 0; j < 8; ++j) { const float gate = w0[j] * g0[j] + w1[j] * g1[j] + w2[j] * g2[j] + bb[j]; v[j] *= gelu_tanh(gate); }
                    *(u32x4*)(out + (size_t)row * DFF + col) = pack8(v);
                    prev = cur; }
                asm volatile("" ::: "memory");
            }
        }
        return false;
    }
};

struct Params { const float* in[30]; float* out; unsigned char* ws; };

__device__ __forceinline__ void transpose_cvt(const float* __restrict__ src, bf16_t* __restrict__ dst, int K, int N, LAS float* tiles, int& job, const bool pair_sc = false) {
    const int tid = tid_opaque(), lane = tid & 63, wv = tid >> 6, tk = K / 64, tn = N / 64, ntile = tk * tn, nwv = (int)gridDim.x * 8, me = (int)blockIdx.x * 8 + wv;
    LAS float* tile = tiles + wv * (64 * 65);
    const int first = ((me - (job % nwv)) % nwv + nwv) % nwv;
    job += ntile;
    for (int t = first; t < ntile; t += nwv) {
        const int k0 = (t / tn) * 64, n0 = (t % tn) * 64;
        int nd = n0; if (pair_sc && n0 >= 3072 && n0 < 5120) { const int sg = (n0 - 3072) >> 10, ch = (n0 - 3072) & 1023; nd = 3072 + (ch >> 7) * 256 + sg * 128 + (ch & 127); }
        f32x4 v[16];
#pragma unroll
        for (int it = 0; it < 16; ++it) v[it] = __builtin_nontemporal_load((const f32x4*)(src + (size_t)(k0 + it * 4 + (lane >> 4)) * N + n0 + (lane & 15) * 4));
#pragma unroll
        for (int it = 0; it < 16; ++it) { const int r = it * 4 + (lane >> 4), c4 = (lane & 15) * 4;
            tile[r * 65 + c4 + 0] = v[it][0]; tile[r * 65 + c4 + 1] = v[it][1]; tile[r * 65 + c4 + 2] = v[it][2]; tile[r * 65 + c4 + 3] = v[it][3]; }
        asm volatile("s_waitcnt lgkmcnt(0)" ::: "memory");
#pragma unroll
        for (int it = 0; it < 8; ++it) { const int n = it * 8 + (lane >> 3), k8 = (lane & 7) * 8; float f[8];
#pragma unroll
            for (int q = 0; q < 8; ++q) f[q] = tile[(k8 + q) * 65 + n];
            *(u32x4*)(dst + (size_t)(nd + n) * K + k0 + k8) = pack8(f); }
        asm volatile("s_waitcnt lgkmcnt(0)" ::: "memory");
    }
}
__device__ __forceinline__ void cvt_rows(const float* __restrict__ src, bf16_t* __restrict__ dst, size_t n8) {
    const size_t G_ = gridDim.x, per0 = (n8 + G_ - 1) / G_, base = (size_t)vblk() * per0, per = base >= n8 ? 0 : (n8 - base < per0 ? n8 - base : per0);
    for (size_t i = tid_opaque(); i < per; i += 4 * 512) { f32x4 a[4], b[4];
#pragma unroll
        for (int q = 0; q < 4; ++q) { const size_t e = i + q * 512; if (e < per) { a[q] = __builtin_nontemporal_load((const f32x4*)(src + (base + e) * 8)); b[q] = __builtin_nontemporal_load((const f32x4*)(src + (base + e) * 8 + 4)); } }
#pragma unroll
        for (int q = 0; q < 4; ++q) { const size_t e = i + q * 512; if (e < per) { float f[8] = {a[q][0], a[q][1], a[q][2], a[q][3], b[q][0], b[q][1], b[q][2], b[q][3]}; *(u32x4*)(dst + (base + e) * 8) = pack8(f); } } }
}
__device__ __forceinline__ void phase_prep(const Params& p, LAS unsigned char* lds) {
    unsigned char* ws = p.ws; LAS float* tile = (LAS float*)lds; int job = 0;
    cvt_rows(p.in[0], (bf16_t*)p.out, (size_t)MT * DM / 8);
    cvt_rows(p.in[1], (bf16_t*)(ws + WS_MEMB), (size_t)1024 * DM / 8);
    transpose_cvt(p.in[2], (bf16_t*)(ws + WS_WIN), 1024, 7168, tile, job, true);
    transpose_cvt(p.in[10], (bf16_t*)(ws + WS_WLRU), 1024, 1024, tile, job);
    transpose_cvt(p.in[12], (bf16_t*)(ws + WS_WSC), 1024, 1024, tile, job);
    transpose_cvt(p.in[14], (bf16_t*)(ws + WS_WMIX), 1024, 1024, tile, job);
    cvt_rows(p.in[17], (bf16_t*)(ws + WS_WQ), (size_t)1024 * 1024 / 8);
    transpose_cvt(p.in[18], (bf16_t*)(ws + WS_WK), 1024, 1024, tile, job);
    transpose_cvt(p.in[19], (bf16_t*)(ws + WS_WV), 1024, 1024, tile, job);
    transpose_cvt(p.in[20], (bf16_t*)(ws + WS_WXO), 1024, 1024, tile, job);
    transpose_cvt(p.in[23], (bf16_t*)(ws + WS_WFG), 1024, 3072, tile, job);
    transpose_cvt(p.in[24], (bf16_t*)(ws + WS_WFU), 1024, 3072, tile, job);
    transpose_cvt(p.in[27], (bf16_t*)(ws + WS_WFD), 3072, 1024, tile, job);
    { const float* wr_ = p.in[5]; const float* wi_ = p.in[7]; bf16_t* wg = (bf16_t*)(ws + WS_WG);
      for (int i = blockIdx.x * 512 + tid_opaque(); i < 2048 * 256; i += gridDim.x * 512) { const int kk = i & 255, rowj = i >> 8, h = rowj >> 8, j = rowj & 255, ii = kk - 128 * (h & 1);
          float v = 0.f; if (ii >= 0 && ii < 128) v = (j < 128) ? wr_[(h * 128 + ii) * 128 + j] : wi_[(h * 128 + ii) * 128 + (j - 128)];
          wg[i] = (bf16_t)(cvt_pk_bf16(v, 0.f) & 0xffffu); } }
    { float* sp = (float*)(ws + WS_SP); const float* lam = p.in[9];
      for (int i = blockIdx.x * 512 + tid_opaque(); i < 1024; i += gridDim.x * 512) { const float x = -lam[i]; const float spl = (x > 20.f) ? x : log1pf(expf(x)); sp[i] = -8.0f * spl; } }
}
__device__ __forceinline__ void phase_conv(const Params& p) {
    const bf16_t* PL = (const bf16_t*)(p.ws + WS_SLOT + 1 * SLOT); const bf16_t* PB = (const bf16_t*)(p.ws + WS_SLOT + 2 * SLOT);
    const bf16_t* PP = (const bf16_t*)(p.ws + WS_SLOT + 3 * SLOT);
    bf16_t* S_ = (bf16_t*)p.out; bf16_t* U_ = (bf16_t*)((unsigned char*)p.out + SLOT);
    const float* lw = p.in[3]; const float* lb = p.in[4]; const float* sw = p.in[11];
    for (int idx = vblk() * 512 + tid_opaque(); idx < 1024 * 128; idx += gridDim.x * 512) {
        const int c = (idx & 127) * 8, row0 = (idx >> 7) * 32;
        float w0[8], w1[8], w2[8], w3[8], bb[8], s0[8], s1[8], s2[8];
#pragma unroll
        for (int j = 0; j < 8; ++j) { w0[j] = lw[c + j]; w1[j] = lw[1024 + c + j]; w2[j] = lw[2048 + c + j]; w3[j] = lw[3072 + c + j]; bb[j] = lb[c + j]; s0[j] = sw[c + j]; s1[j] = sw[1024 + c + j]; s2[j] = sw[2048 + c + j]; }
        float l1[8], l2[8], l3[8], p1[8], p2[8];
        if ((row0 & (SEQ - 1)) != 0) { const size_t o = (size_t)row0 * 1024 + c;
            unpack8(*(const u32x4*)(PL + o - 1024), l1); unpack8(*(const u32x4*)(PL + o - 2048), l2); unpack8(*(const u32x4*)(PL + o - 3072), l3);
            unpack8(*(const u32x4*)(PP + o - 1024), p1); unpack8(*(const u32x4*)(PP + o - 2048), p2);
        } else {
#pragma unroll
            for (int j = 0; j < 8; ++j) { l1[j] = 0.f; l2[j] = 0.f; l3[j] = 0.f; p1[j] = 0.f; p2[j] = 0.f; } }
#pragma unroll 4
        for (int t = 0; t < 32; ++t) { const size_t o = (size_t)(row0 + t) * 1024 + c;
            float l0[8], vb[8], vp[8]; unpack8(__builtin_nontemporal_load((const u32x4*)(PL + o)), l0); unpack8(__builtin_nontemporal_load((const u32x4*)(PB + o)), vb); unpack8(__builtin_nontemporal_load((const u32x4*)(PP + o)), vp);
            float uo[8], so[8];
#pragma unroll
            for (int j = 0; j < 8; ++j) { uo[j] = w0[j] * l0[j] + w1[j] * l1[j] + w2[j] * l2[j] + w3[j] * l3[j] + bb[j];
                const float p0 = vp[j]; so[j] = vb[j] * (s0[j] * p0 + s1[j] * p1[j] + s2[j] * p2[j]);
                l3[j] = l2[j]; l2[j] = l1[j]; l1[j] = l0[j]; p2[j] = p1[j]; p1[j] = p0; }
            *(u32x4*)(U_ + o) = pack8(uo); *(u32x4*)(S_ + o) = pack8(so); }
    }
}
__device__ __forceinline__ void phase_scan1(const Params& p) {
    const unsigned* LA = (const unsigned*)(p.ws + WS_SLOT + 1 * SLOT); const unsigned* BT = (const unsigned*)(p.ws + WS_SLOT + 2 * SLOT);
    f32x2* AGA = (f32x2*)(p.ws + WS_AGG); f32x2* AGH = (f32x2*)(p.ws + WS_AGG + MiB);
    for (int idx = vblk() * 512 + tid_opaque(); idx < 256 * 512; idx += gridDim.x * 512) {
        const int cp = idx & 511, ck = idx >> 9; const size_t o0 = (size_t)ck * 128 * 512 + cp;
        f32x2 h = (f32x2){0.f, 0.f}, ls = (f32x2){0.f, 0.f};
#pragma unroll 16
        for (int t = 0; t < 128; ++t) { const f32x2 l = unpack_h2(LA[o0 + (size_t)t * 512]), b = unpack_h2(BT[o0 + (size_t)t * 512]);
            ls += l; h.x = __builtin_amdgcn_exp2f(l.x * 1.4426950408889634f) * h.x + b.x; h.y = __builtin_amdgcn_exp2f(l.y * 1.4426950408889634f) * h.y + b.y; }
        AGA[idx] = ls; AGH[idx] = h;
    }
}
__device__ __forceinline__ void phase_scan3(const Params& p) {
    const unsigned* LA = (const unsigned*)(p.ws + WS_SLOT + 1 * SLOT); const unsigned* BT = (const unsigned*)(p.ws + WS_SLOT + 2 * SLOT);
    const unsigned* PG = (const unsigned*)(p.ws + WS_SLOT + 0 * SLOT); unsigned* YL = (unsigned*)(p.ws + WS_SLOT + 3 * SLOT);
    const f32x2* AGA = (const f32x2*)(p.ws + WS_AGG); const f32x2* AGH = (const f32x2*)(p.ws + WS_AGG + MiB);
    for (int idx = vblk() * 512 + tid_opaque(); idx < 256 * 512; idx += gridDim.x * 512) {
        const int cp = idx & 511, ck = idx >> 9, ckb = ck & ~63; const size_t o0 = (size_t)ck * 128 * 512 + cp;
        f32x2 h = (f32x2){0.f, 0.f};
#pragma unroll 8
        for (int j = ckb; j < ck; ++j) { const f32x2 a = AGA[j * 512 + cp], hh = AGH[j * 512 + cp];
            h.x = __builtin_amdgcn_exp2f(a.x * 1.4426950408889634f) * h.x + hh.x; h.y = __builtin_amdgcn_exp2f(a.y * 1.4426950408889634f) * h.y + hh.y; }
#pragma unroll 16
        for (int t = 0; t < 128; ++t) { const size_t o = o0 + (size_t)t * 512; const f32x2 l = unpack_h2(__builtin_nontemporal_load(LA + o)), b = unpack_h2(__builtin_nontemporal_load(BT + o)); const unsigned gw = __builtin_nontemporal_load(PG + o);
            h.x = __builtin_amdgcn_exp2f(l.x * 1.4426950408889634f) * h.x + b.x; h.y = __builtin_amdgcn_exp2f(l.y * 1.4426950408889634f) * h.y + b.y;
            YL[o] = cvt_pk_bf16(bf_lo(gw) * h.x, bf_hi(gw) * h.y); }
    }
}
__device__ __forceinline__ void phase_ln(const unsigned short* xh, const float* g, const float* b, bf16_t* xb, float* xf) {
    const int tid = tid_opaque(); const int lane = tid & 63, nw = gridDim.x * 8, rpw = (MT + nw - 1) / nw, wv = vblk() * 8 + (tid >> 6);
    float gv[2][8], bv[2][8];
#pragma unroll
    for (int j = 0; j < 2; ++j) { const f32x4 g0 = *(const f32x4*)(g + j * 512 + lane * 8), g1 = *(const f32x4*)(g + j * 512 + lane * 8 + 4), b0 = *(const f32x4*)(b + j * 512 + lane * 8), b1 = *(const f32x4*)(b + j * 512 + lane * 8 + 4);
#pragma unroll
        for (int e = 0; e < 4; ++e) { gv[j][e] = g0[e]; gv[j][4 + e] = g1[e]; bv[j][e] = b0[e]; bv[j][4 + e] = b1[e]; } }
    const int rend = ((wv + 1) * rpw < MT) ? (wv + 1) * rpw : MT;
    for (int rowa = wv * rpw; rowa < rend; rowa += 2) {
        const int rowb = (rowa + 1 < rend) ? rowa + 1 : rowa; const bool hb = rowa + 1 < rend;
        float v[2][2][8];
#pragma unroll
        for (int r = 0; r < 2; ++r)
#pragma unroll
            for (int j = 0; j < 2; ++j) { const u32x4 w = __builtin_nontemporal_load((const u32x4*)(xh + (size_t)(r ? rowb : rowa) * 1024 + j * 512 + lane * 8));
                const f32x2 p0 = unpack_h2(w.x), p1 = unpack_h2(w.y), p2 = unpack_h2(w.z), p3 = unpack_h2(w.w);
                v[r][j][0] = p0.x; v[r][j][1] = p0.y; v[r][j][2] = p1.x; v[r][j][3] = p1.y; v[r][j][4] = p2.x; v[r][j][5] = p2.y; v[r][j][6] = p3.x; v[r][j][7] = p3.y; }
        float s[2] = {0.f, 0.f}, q[2] = {0.f, 0.f};
#pragma unroll
        for (int r = 0; r < 2; ++r)
#pragma unroll
            for (int j = 0; j < 2; ++j)
#pragma unroll
                for (int e = 0; e < 8; ++e) s[r] += v[r][j][e];
#pragma unroll
        for (int o = 32; o >= 1; o >>= 1) { s[0] += __shfl_xor(s[0], o); s[1] += __shfl_xor(s[1], o); }
#pragma unroll
        for (int r = 0; r < 2; ++r) { const float mean = s[r] * (1.0f / 1024.0f);
#pragma unroll
            for (int j = 0; j < 2; ++j)
#pragma unroll
                for (int e = 0; e < 8; ++e) { v[r][j][e] -= mean; q[r] += v[r][j][e] * v[r][j][e]; } }
#pragma unroll
        for (int o = 32; o >= 1; o >>= 1) { q[0] += __shfl_xor(q[0], o); q[1] += __shfl_xor(q[1], o); }
#pragma unroll
        for (int r = 0; r < 2; ++r) { if (r == 1 && !hb) break; const int row = r ? rowb : rowa; const float rstd2 = 1.0f / __builtin_sqrtf(q[r] * (1.0f / 1024.0f) + LN_EPS);
#pragma unroll
            for (int j = 0; j < 2; ++j) { float y[8];
#pragma unroll
                for (int e = 0; e < 8; ++e) y[e] = v[r][j][e] * rstd2 * gv[j][e] + bv[j][e];
                const size_t off = (size_t)row * 1024 + j * 512 + lane * 8;
                if (xb) *(u32x4*)(xb + off) = pack8(y);
                if (xf) { *(f32x4*)(xf + off) = (f32x4){y[0], y[1], y[2], y[3]}; *(f32x4*)(xf + off + 4) = (f32x4){y[4], y[5], y[6], y[7]}; } } }
    }
}


#define XB_TMO      128
#define XB_XCNT(j)  (256  + 64 * (j))
#define XB_XSUB(j)  (1280 + 64 * (j))
#define XB_XGEN(j)  (2304 + 64 * (j))
#define XB_TOP      3328
#define XB_TOPGEN   3392
#define XCD_BAR_WORDS 3456
#define XB_SPIN_CAP (1u << 18)
__device__ __forceinline__ unsigned xb_ld(unsigned* p)              { return __hip_atomic_load(p, __ATOMIC_RELAXED, __HIP_MEMORY_SCOPE_AGENT); }
__device__ __forceinline__ unsigned xb_add(unsigned* p, unsigned v) { return __hip_atomic_fetch_add(p, v, __ATOMIC_RELAXED, __HIP_MEMORY_SCOPE_AGENT); }
__device__ __forceinline__ unsigned xb_xcc_id() { return (unsigned)__builtin_amdgcn_s_getreg((3 << 11) | 20) & 0xFu; }
#define XB_SPIN(cond, bar) do { unsigned _sp = 0; while (cond) { __builtin_amdgcn_s_sleep(1); \
    if ((++_sp & 255u) == 0u) { if (xb_ld(&(bar)[XB_TMO])) break; if (_sp > XB_SPIN_CAP) { atomicAdd(&(bar)[XB_TMO], 1u); break; } } } } while (0)
struct XcdBarrier { unsigned* bar; unsigned x; volatile LAS unsigned* st; };
__device__ __forceinline__ XcdBarrier xcd_barrier_post(unsigned* bar, volatile LAS unsigned* st) {
    XcdBarrier b; b.bar = bar; b.x = xb_xcc_id(); b.st = st;
    if (threadIdx.x == 0) (void)xb_add(&bar[XB_XCNT(b.x)], 1u);
    return b;
}
__device__ __forceinline__ void xcd_barrier_complete(unsigned* bar, unsigned x, unsigned& nloc, unsigned& nx) {
    const unsigned G = gridDim.x * gridDim.y * gridDim.z;
    unsigned sum, cnt, mine, sp = 0u;
    for (;;) {
        sum = 0u; cnt = 0u; mine = 0u;
#pragma unroll
        for (unsigned j = 0; j < 16; ++j) { const unsigned c = xb_ld(&bar[XB_XCNT(j)]); sum += c; cnt += (c > 0u) ? 1u : 0u; mine = (j == x) ? c : mine; }
        if (sum == G) break;
        __builtin_amdgcn_s_sleep(1);
        if ((++sp & 255u) == 0u) { if (xb_ld(&bar[XB_TMO])) break; if (sp > XB_SPIN_CAP) { atomicAdd(&bar[XB_TMO], 1u); break; } }
    }
    nloc = mine > 0u ? mine : 1u; nx = cnt > 0u ? cnt : 1u;
}
__device__ __forceinline__ void xcd_barrier(const XcdBarrier& b) {
    asm volatile("s_waitcnt vmcnt(0)" ::: "memory");
    __syncthreads();
    if (threadIdx.x == 0) {
        unsigned* bar = b.bar;
        __builtin_amdgcn_s_waitcnt(0);
        unsigned nloc = b.st[0], nx = b.st[1];
        if (nloc == 0u) { xcd_barrier_complete(bar, b.x, nloc, nx); b.st[0] = nloc; b.st[1] = nx; }
        const unsigned old = xb_add(&bar[XB_XSUB(b.x)], 1u);
        const unsigned gen = old / nloc;
        if (old + 1u == (gen + 1u) * nloc) {
            __builtin_amdgcn_fence(__ATOMIC_RELEASE, "agent");
            asm volatile("s_waitcnt vmcnt(0)" ::: "memory");
            const unsigned og = xb_add(&bar[XB_TOP], 1u);
            const unsigned tg = og / nx;
            if (og + 1u == (tg + 1u) * nx) xb_add(&bar[XB_TOPGEN], 1u);
            else XB_SPIN(xb_ld(&bar[XB_TOPGEN]) == tg, bar);
            __builtin_amdgcn_fence(__ATOMIC_ACQUIRE, "agent");
            xb_add(&bar[XB_XGEN(b.x)], 1u);
            asm volatile("s_waitcnt vmcnt(0)" ::: "memory");
        } else {
            XB_SPIN(xb_ld(&bar[XB_XGEN(b.x)]) == gen, bar);
            __builtin_amdgcn_fence(__ATOMIC_ACQUIRE, "agent");
            asm volatile("s_waitcnt vmcnt(0)" ::: "memory");
        }
    }
    __syncthreads();
}


__device__ __forceinline__ void xb2_barrier(unsigned* bar, unsigned x, unsigned nloc, unsigned nx, unsigned k) {
    asm volatile("s_waitcnt vmcnt(0)" ::: "memory");
    __syncthreads();
    if (threadIdx.x == 0) {
        const unsigned old = xb_add(&bar[XB_XSUB(x)], 1u);
        if (old + 1u == (k + 1u) * nloc) {
            __builtin_amdgcn_fence(__ATOMIC_RELEASE, "agent");
            asm volatile("s_waitcnt vmcnt(0)" ::: "memory");
            (void)xb_add(&bar[XB_TOP], 1u);
        }
        while (xb_ld(&bar[XB_TOP]) < (k + 1u) * nx) __builtin_amdgcn_s_sleep(1);
        __builtin_amdgcn_fence(__ATOMIC_ACQUIRE, "agent");
        asm volatile("s_waitcnt vmcnt(0)" ::: "memory");
    }
    __syncthreads();
}
__global__ void __launch_bounds__(512, 2) fwd_megakernel(Params p) {
    extern __shared__ __attribute__((aligned(16))) unsigned char shm[];
    LAS unsigned char* lds = (LAS unsigned char*)shm;
    cg::grid_group grid = cg::this_grid();
    unsigned char* ws = p.ws; const int G = gridDim.x, c = blockIdx.x;
    const size_t TS = (size_t)256 * 1024 * 2;
    bf16_t* slot0 = (bf16_t*)(ws + WS_SLOT);
#define slot(i) ((bf16_t*)(ws + WS_SLOT + (size_t)(i) * SLOT))
    float* O = p.out; bf16_t* O_lo = (bf16_t*)p.out; bf16_t* O_hi = (bf16_t*)((unsigned char*)p.out + SLOT);

    unsigned* const xbar = (unsigned*)(ws + WS_BAR); unsigned* const xtab = xbar + 4096; const unsigned xcc = xb_xcc_id();
    if (blockIdx.x == 0) for (int i = threadIdx.x; i < XCD_BAR_WORDS; i += 512) __hip_atomic_store(&xbar[i], 0u, __ATOMIC_RELAXED, __HIP_MEMORY_SCOPE_AGENT);
    if (threadIdx.x == 0) __hip_atomic_store(&xtab[blockIdx.x], xcc, __ATOMIC_RELAXED, __HIP_MEMORY_SCOPE_AGENT);
    unsigned xb_nloc = 1u, xb_nx = 1u, xb_k = 0u;
#define GSYNC() do { xb2_barrier(xbar, xcc, xb_nloc, xb_nx, xb_k); ++xb_k; } while (0)
#define WGSYNC() do { asm volatile("s_waitcnt vmcnt(0)" ::: "memory"); __syncthreads(); if (threadIdx.x == 0) { __builtin_amdgcn_fence(__ATOMIC_ACQUIRE, "agent"); asm volatile("s_waitcnt vmcnt(0)" ::: "memory"); } __syncthreads(); } while (0)
    {
    phase_prep(p, lds);
    }
    grid.sync();
    { unsigned mine = 0u, present = 0u; const int lane_ = threadIdx.x & 63;
      for (int base = 0; base < (int)gridDim.x; base += 64) { const int e = base + lane_; const unsigned v = (e < (int)gridDim.x) ? xb_ld(&xtab[e]) : 0xffu;
          mine += (unsigned)__builtin_popcountll(__builtin_amdgcn_ballot_w64(v == xcc));
#pragma unroll
          for (unsigned id = 0; id < 16; ++id) present |= (__builtin_amdgcn_ballot_w64(v == id) != 0ull) ? (1u << id) : 0u; }
      xb_nloc = (unsigned)__builtin_amdgcn_readfirstlane((int)mine); xb_nx = (unsigned)__builtin_amdgcn_readfirstlane((int)__builtin_popcount(present)); }
    {
    { SchedProj S; S.o.init(128, 28, G, c); S.xb = (const char*)O_lo; S.win = (const char*)(ws + WS_WIN); S.memb = (const char*)(ws + WS_MEMB); S.wk = (const char*)(ws + WS_WK); S.wv = (const char*)(ws + WS_WV);
      EpiProj E{slot0, p.in[13], (bf16_t*)(ws + WS_KB), (bf16_t*)(ws + WS_VT)};
      gemm_phase(lds, 1024, 1024, 1024, S, E); }
    }
    GSYNC();
    {
    phase_conv(p);
    { SchedKVS S; S.G = G; S.c = c; S.memb = (const char*)(ws + WS_MEMB); S.wk = (const char*)(ws + WS_WK); S.wv = (const char*)(ws + WS_WV);
      EpiPart E{(float*)slot(4)};
      gemm_phase(lds, 1024, 1024, 256, S, E); }
    }
    GSYNC();
    {
    { SchedG S; S.o.init(128, 8, G, c); S.A = (const char*)O_hi; S.B = (const char*)(ws + WS_WG); S.a_pm = TS; S.a_pn = 512; S.a_sh = 1; S.b_pn = (size_t)256 * 256 * 2; S.b_pb = 0;
      EpiGates E{O_hi, p.in[6], p.in[8], (const float*)(ws + WS_SP), (unsigned short*)slot(1), (unsigned short*)slot(2)};
      gemm_phase(lds, 1024, 256, 256, S, E); }
    { const float* part = (const float*)slot(4); bf16_t* kb = (bf16_t*)(ws + WS_KB); bf16_t* vb = (bf16_t*)(ws + WS_VT);
      for (int i = blockIdx.x * 512 + tid_opaque(); i < 2 * 1024 * 128; i += gridDim.x * 512) { const int mat = i >> 17, e8 = (i & 131071) * 8; const float* q = part + (size_t)mat * 4 * 1024 * 1024 + e8;
          f32x4 a = *(const f32x4*)q, b = *(const f32x4*)(q + 4);
#pragma unroll
          for (int ks = 1; ks < 4; ++ks) { a += *(const f32x4*)(q + (size_t)ks * 1024 * 1024); b += *(const f32x4*)(q + (size_t)ks * 1024 * 1024 + 4); }
          float f[8] = {a[0], a[1], a[2], a[3], b[0], b[1], b[2], b[3]}; *(u32x4*)((mat ? vb : kb) + e8) = pack8(f); } }
    }
    GSYNC();
    {
    phase_scan1(p);
    { SchedPre S; S.G = G; S.c = c; S.kb = (const char*)(ws + WS_KB); S.wq = (const char*)(ws + WS_WQ); S.wxo = (const char*)(ws + WS_WXO); S.vb = (const char*)(ws + WS_VT);
      EpiPre E{(bf16_t*)O_hi, (bf16_t*)O_hi + (size_t)16 * 256 * 1024};
      gemm_phase(lds, 1024, 1024, 256, S, E); }
    }
    GSYNC();
    {
    phase_scan3(p);
    }
    GSYNC();
    {
    { SchedMerge S; S.o.init(128, 4, G, c); S.A1 = (const char*)slot(3); S.B1 = (const char*)(ws + WS_WLRU); S.A2 = (const char*)O_lo; S.B2 = (const char*)(ws + WS_WSC);
      EpiMerge E{slot(5), slot(6), slot(4)};
      gemm_phase(lds, 1024, 1024, 1024, S, E); }
    }
    GSYNC();
    {
    { SchedG S; S.o.init(128, 4, G, c); S.A = (const char*)slot(4); S.B = (const char*)(ws + WS_WMIX); S.a_pm = TS; S.a_pn = 0; S.a_sh = 0; S.b_pn = TS; S.b_pb = 0;
      EpiRes E{p.in[0], (unsigned short*)O};
      gemm_phase(lds, 1024, 1024, 1024, S, E); }
    }
    GSYNC();
    {
    phase_ln((const unsigned short*)O, p.in[15], p.in[16], slot(3), nullptr);
    }
    GSYNC();
    {
    { SchedG S; S.o.init(128, 4, G, c); S.A = (const char*)slot(3); S.B = (const char*)O_hi; S.a_pm = TS; S.a_pn = 0; S.a_sh = 0; S.b_pn = TS; S.b_pb = 4 * TS;
      EpiScoreN E{slot(4)};
      gemm_phase(lds, 1024, 1024, 1024, S, E); }
    }
    GSYNC();
    {
    { SchedG S; S.o.init(128, 4, G, c); S.A = (const char*)slot(4); S.B = (const char*)((bf16_t*)O_hi + (size_t)16 * 256 * 1024); S.a_pm = TS; S.a_pn = 0; S.a_sh = 0; S.b_pn = TS; S.b_pb = 4 * TS;
      EpiResB E{slot(3), (unsigned short*)O};
      gemm_phase(lds, 1024, 1024, 1024, S, E); }
    }
    GSYNC();
    {
    phase_ln((const unsigned short*)O, p.in[21], p.in[22], slot(3), nullptr);
    }
    GSYNC();
    {
    { SchedG S; S.o.init(128, 12, G, c); S.A = (const char*)slot(3); S.B = (const char*)(ws + WS_WFG); S.a_pm = TS; S.a_pn = 0; S.a_sh = 0; S.b_pn = TS; S.b_pb = 0;
      EpiBf16 E{slot(4), DFF, 1.0f};
      gemm_phase(lds, 1024, 1024, 1024, S, E); }
    }
    GSYNC();
    {
    { SchedG S; S.o.init(128, 12, G, c); S.A = (const char*)slot(3); S.B = (const char*)(ws + WS_WFU); S.a_pm = TS; S.a_pn = 0; S.a_sh = 0; S.b_pn = TS; S.b_pb = 0;
      EpiFfnUp E{slot(4), p.in[25], p.in[26], slot(0)};
      gemm_phase(lds, 1024, 1024, 1024, S, E); }
    }
    GSYNC();
    {
    { SchedG S; S.o.init(128, 4, G, c); S.A = (const char*)slot(0); S.B = (const char*)(ws + WS_WFD); S.a_pm = (size_t)256 * DFF * 2; S.a_pn = 0; S.a_sh = 0; S.b_pn = (size_t)256 * DFF * 2; S.b_pb = 0;
      EpiResB E{slot(3), (unsigned short*)slot(4)};
      gemm_phase(lds, DFF, DFF, DFF, S, E); }
    }
    GSYNC();
    {
    phase_ln((const unsigned short*)slot(4), p.in[28], p.in[29], nullptr, O);
    }
}

extern "C" void kernel_launch(void* const* d_in, const int* in_sizes, int n_in, void* d_out, int out_size, void* d_ws, size_t ws_size, hipStream_t stream) {
    static int grid_blocks = 0;
    if (grid_blocks == 0) {
        if (n_in != 30 || out_size != MT * DM || ws_size < WS_END) { fprintf(stderr, "kernel_launch: unexpected shapes (n_in %d out %d ws %zu, need %zu)\n", n_in, out_size, ws_size, (size_t)WS_END); grid_blocks = -1; return; }
        int dev = 0, cus = 0, per_cu = 0;
        (void)hipGetDevice(&dev);
        (void)hipDeviceGetAttribute(&cus, hipDeviceAttributeMultiprocessorCount, dev);
        if (hipFuncSetAttribute((const void*)fwd_megakernel, hipFuncAttributeMaxDynamicSharedMemorySize, LDS_BYTES) != hipSuccess) { fprintf(stderr, "kernel_launch: hipFuncSetAttribute failed\n"); grid_blocks = -1; return; }
        if (hipOccupancyMaxActiveBlocksPerMultiprocessor(&per_cu, (const void*)fwd_megakernel, 512, LDS_BYTES) != hipSuccess || per_cu < 1) { fprintf(stderr, "kernel_launch: occupancy query failed (%d)\n", per_cu); grid_blocks = -1; return; }
        grid_blocks = cus * 1;
    }
    if (grid_blocks < 0) return;
    Params p{};
    for (int i = 0; i < 30; ++i) p.in[i] = (const float*)d_in[i];
    p.out = (float*)d_out; p.ws = (unsigned char*)d_ws;
    void* args[] = {&p};
    hipError_t e = hipLaunchCooperativeKernel((const void*)fwd_megakernel, dim3(grid_blocks), dim3(512), args, LDS_BYTES, stream);
    if (e != hipSuccess) fprintf(stderr, "cooperative launch failed: %s (grid %d)\n", hipGetErrorString(e), grid_blocks);
}
```

```cpp
#include <hip/hip_runtime.h>
#include <hip/hip_cooperative_groups.h>
#include <cstdio>
namespace cg = cooperative_groups;

#define LAS __attribute__((address_space(3)))
typedef unsigned short bf16_t;
typedef short bf16x8 __attribute__((ext_vector_type(8)));
typedef float f32x4 __attribute__((ext_vector_type(4)));
typedef float f32x2 __attribute__((ext_vector_type(2)));
typedef unsigned u32x4 __attribute__((ext_vector_type(4)));
typedef unsigned u32x2 __attribute__((ext_vector_type(2)));
typedef _Float16 h16x2 __attribute__((ext_vector_type(2)));

constexpr int MT = 32768, DM = 1024, SEQ = 8192, NMEM = 256, DFF = 3072;
constexpr float ALPHA = 1.189207115002721f, LN_EPS = 1e-5f;
constexpr size_t MiB = (size_t)1 << 20;
constexpr size_t WS_WIN = 0, WS_WG = 14 * MiB, WS_WLRU = 15 * MiB, WS_WSC = 17 * MiB, WS_WMIX = 19 * MiB, WS_WQ = 21 * MiB, WS_WK = 23 * MiB, WS_WV = 25 * MiB,
                 WS_WXO = 27 * MiB, WS_WFG = 29 * MiB, WS_WFU = 35 * MiB, WS_WFD = 41 * MiB, WS_MEMB = 47 * MiB, WS_KB = 49 * MiB, WS_VT = 51 * MiB, WS_RS = 53 * MiB,
                 WS_AGG = 55 * MiB, WS_SP = 57 * MiB, WS_SLOT = 58 * MiB, SLOT = 64 * MiB, WS_END = WS_SLOT + 7 * SLOT;
constexpr int LDS_STAGE = 131072, LDS_XB = LDS_STAGE + 4096, LDS_BYTES = LDS_STAGE + 8192;
constexpr size_t WS_BAR = WS_SP + 65536;

__device__ __forceinline__ unsigned cvt_pk_bf16(float lo, float hi) { unsigned r; asm volatile("v_cvt_pk_bf16_f32 %0, %1, %2" : "=v"(r) : "v"(lo), "v"(hi)); return r; }
__device__ __forceinline__ float bf_lo(unsigned w) { return __uint_as_float(w << 16); }
__device__ __forceinline__ float bf_hi(unsigned w) { return __uint_as_float(w & 0xffff0000u); }
__device__ __forceinline__ void unpack8(const u32x4 w, float (&f)[8]) { f[0] = bf_lo(w.x); f[1] = bf_hi(w.x); f[2] = bf_lo(w.y); f[3] = bf_hi(w.y); f[4] = bf_lo(w.z); f[5] = bf_hi(w.z); f[6] = bf_lo(w.w); f[7] = bf_hi(w.w); }
__device__ __forceinline__ u32x4 pack8(const float (&f)[8]) { u32x4 w; w.x = cvt_pk_bf16(f[0], f[1]); w.y = cvt_pk_bf16(f[2], f[3]); w.z = cvt_pk_bf16(f[4], f[5]); w.w = cvt_pk_bf16(f[6], f[7]); return w; }
__device__ __forceinline__ float sigmoidf_(float x) { return __builtin_amdgcn_rcpf(1.0f + __builtin_amdgcn_exp2f(-1.4426950408889634f * x)); }
__device__ __forceinline__ float gelu_tanh(float x) { const float z = 1.5957691216057308f * (x + 0.044715f * x * x * x); return x * sigmoidf_(z); }
__device__ __forceinline__ unsigned pack_h2(float a, float b) { h16x2 h; h.x = (_Float16)a; h.y = (_Float16)b; return __builtin_bit_cast(unsigned, h); }
__device__ __forceinline__ f32x2 unpack_h2(unsigned w) { const h16x2 h = __builtin_bit_cast(h16x2, w); return (f32x2){(float)h.x, (float)h.y}; }

__device__ __forceinline__ int tid_opaque() { int t = threadIdx.x; asm volatile("" : "+v"(t)); return t; }

__device__ __forceinline__ int vblk() { const int b = blockIdx.x; return (gridDim.x == 256) ? ((b & 7) * 32 + (b >> 3)) : b; }
__device__ __forceinline__ float bperm_xor(float x, int lane_op, int mask) { return __int_as_float(__builtin_amdgcn_ds_bpermute((lane_op ^ mask) << 2, __float_as_int(x))); }

constexpr int BM = 256, BK = 64, HALF = 128, HTB = HALF * BK * 2;
__device__ __forceinline__ int lds_byte(int r, int c) { const int st = (r >> 4) * 2 + (c >> 5), rr = r & 15, cc = c & 31, ob = rr * 64 + cc * 2; return st * 1024 + (ob ^ (((ob >> 9) & 1) << 5)); }
__device__ __forceinline__ void stage_rc(int b, int& R, int& C) { const int st = b / 1024, sb = b % 1024, swz = sb ^ (((sb >> 9) & 1) << 5); R = (st >> 1) * 16 + swz / 64; C = (st & 1) * 32 + (swz % 64) / 2; }
__device__ __forceinline__ int perm32(int rho) { const int n = rho >> 4, i = rho & 15; return 8 * (i >> 2) + 4 * n + (i & 3); }

struct Unit { int pm, pn, kind; const char* a; const char* b; };

struct TileOrder {
    int nM, nN, nwg, G, c;
    __device__ __forceinline__ void init(int nM_, int nN_, int G_, int c_) { nM = nM_; nN = nN_; nwg = nM_ * nN_; G = G_; c = c_; }
    __device__ __forceinline__ bool map(int L, int& pm, int& pn) const {
        if (L >= nwg) return false;
        int wgid = L; { const int q = nwg / 8, r = nwg % 8, xcd = wgid % 8, off = wgid / 8; wgid = (xcd < r ? xcd * (q + 1) : r * (q + 1) + (xcd - r) * q) + off; }
        const int nig = 8 * nN, gid = wgid / nig, fm = gid * 8, gsz = (nM - fm) < 8 ? (nM - fm) : 8;
        pm = fm + ((wgid % nig) % gsz); pn = (wgid % nig) / gsz; return true;
    }
};
struct SchedG {
    TileOrder o; const char* A; const char* B; size_t a_pm, a_pn; int a_sh; size_t b_pn, b_pb;
    __device__ __forceinline__ bool next(int i, Unit& u) const {
        if (!o.map(i * o.G + o.c, u.pm, u.pn)) return false;
        u.kind = 0; u.a = A + (size_t)u.pm * a_pm + (size_t)(u.pn >> a_sh) * a_pn; u.b = B + (size_t)u.pn * b_pn + (size_t)(u.pm >> 5) * b_pb; return true; }
};
struct SchedMerge {
    TileOrder o; const char* A1; const char* B1; const char* A2; const char* B2;
    __device__ __forceinline__ bool next(int i, Unit& u) const {
        if (!o.map((i >> 1) * o.G + o.c, u.pm, u.pn)) return false;
        u.kind = i & 1; const size_t ts = (size_t)256 * 1024 * 2;
        u.a = (u.kind ? A2 : A1) + (size_t)u.pm * ts; u.b = (u.kind ? B2 : B1) + (size_t)u.pn * ts; return true; }
};
struct SchedProj {
    TileOrder o; const char* xb; const char* win; const char* memb; const char* wk; const char* wv;
    __device__ __forceinline__ bool next(int i, Unit& u) const {
        const int L = i * o.G + o.c; const size_t ts = (size_t)256 * 1024 * 2;
        if (o.map(L, u.pm, u.pn)) { u.kind = 0; u.a = xb + (size_t)u.pm * ts; u.b = win + (size_t)u.pn * ts; return true; }
        const int e = L - o.nwg; if (e >= 0) return false;
        if (e < 16) { u.kind = 1; u.pm = e >> 2; u.pn = e & 3; u.a = memb + (size_t)u.pm * ts; u.b = wk + (size_t)u.pn * ts; }
        else { const int f = e - 16; u.kind = 2; u.pm = f >> 2; u.pn = f & 3; u.a = memb + (size_t)u.pm * ts; u.b = wv + (size_t)u.pn * ts; }
        return true; }
};

typedef f32x4 Acc[2][2][4][2];

template <class Epi, class Sched>
__device__ __forceinline__ void gemm_phase(LAS unsigned char* lds, const int lda, const int ldb, const int K, const Sched& S, const Epi& E) {
    int tid_ = threadIdx.x; asm volatile("" : "+v"(tid_));
    const int tid = tid_, wid = __builtin_amdgcn_readfirstlane(tid >> 6), lane = tid & 63, wr = wid >> 2, wc = wid & 3, fr = lane & 15, fq = lane >> 4;
    const int nt = K / BK;
    unsigned voffA[2], voffB[2];
#pragma unroll
    for (int i = 0; i < 2; ++i) { int R, C; stage_rc(tid * 16 + i * 8192, R, C); const int Rb = (R & ~31) + perm32(R & 31);
        voffA[i] = (unsigned)(R * lda + C) * 2u; voffB[i] = (unsigned)(Rb * ldb + C) * 2u; }
    const size_t kstep = (size_t)(BK * 2);
    const size_t hstepA = (size_t)HALF * lda * 2, hstepB = (size_t)HALF * ldb * 2;
    const unsigned ldsw = (unsigned)wid * 1024u;
    const int aoff = lds_byte(wr * 64 + fr, fq * 8), boff = lds_byte(wc * 32 + fr, fq * 8);
    LAS unsigned char* xl = lds + LDS_STAGE;
#define PG8_SA(b, h) (((b) * 2 + (h)) * HTB)
#define PG8_SB(b, h) ((4 + (b) * 2 + (h)) * HTB)
#define PG8_STAGE(bufoff, gbase, voff) do { _Pragma("unroll") for (int _i = 0; _i < 2; ++_i) \
        __builtin_amdgcn_global_load_lds((const unsigned*)((const char*)(gbase) + (voff)[_i]), (LAS unsigned*)(lds + (bufoff) + ldsw + _i * 8192), 16, 0, 0); } while (0)
#define PG8_LDA(dst, b, h) do { _Pragma("unroll") for (int m = 0; m < 4; ++m) _Pragma("unroll") for (int k = 0; k < 2; ++k) dst[m][k] = *(const LAS bf16x8*)(lds + PG8_SA(b, h) + aoff + m * 2048 + k * 1024); } while (0)
#define PG8_LDB(dst, b, h) do { _Pragma("unroll") for (int n = 0; n < 2; ++n) _Pragma("unroll") for (int k = 0; k < 2; ++k) dst[n][k] = *(const LAS bf16x8*)(lds + PG8_SB(b, h) + boff + n * 2048 + k * 1024); } while (0)
#define PG8_MMA(ai, bj, At, Bt) do { __builtin_amdgcn_s_setprio(1); _Pragma("unroll") for (int m = 0; m < 4; ++m) _Pragma("unroll") for (int n = 0; n < 2; ++n) _Pragma("unroll") for (int k = 0; k < 2; ++k) \
        acc[ai][bj][m][n] = __builtin_amdgcn_mfma_f32_16x16x32_bf16(Bt[n][k], At[m][k], acc[ai][bj][m][n], 0, 0, 0); __builtin_amdgcn_s_setprio(0); } while (0)
#define PG8_WAIT_V(n) asm volatile("s_waitcnt vmcnt(" #n ")" ::: "memory")
#define PG8_WAIT_L(n) asm volatile("s_waitcnt lgkmcnt(" #n ")" ::: "memory")
#define PG8_BAR __builtin_amdgcn_s_barrier()
#define PG8_SCHED __builtin_amdgcn_sched_barrier(0)
    Unit cur, nxt; int ui = 0;
    if (!S.next(0, cur)) return;
    Acc acc;
#pragma unroll
    for (int a = 0; a < 2; ++a)
#pragma unroll
        for (int b = 0; b < 2; ++b)
#pragma unroll
            for (int m = 0; m < 4; ++m)
#pragma unroll
                for (int n = 0; n < 2; ++n) acc[a][b][m][n] = (f32x4){0.f, 0.f, 0.f, 0.f};
    bf16x8 At[4][2], B0[2][2], B1[2][2];
    const char* cA = cur.a; const char* cB = cur.b;
    PG8_STAGE(PG8_SB(0, 0), cB, voffB); PG8_STAGE(PG8_SB(0, 1), cB + hstepB, voffB); PG8_STAGE(PG8_SA(0, 0), cA, voffA); PG8_STAGE(PG8_SA(0, 1), cA + hstepA, voffA);
    if (wr == 1) PG8_BAR;
    PG8_WAIT_V(2); PG8_BAR;
    PG8_STAGE(PG8_SB(1, 0), cB + kstep, voffB); PG8_STAGE(PG8_SA(1, 0), cA + kstep, voffA); PG8_STAGE(PG8_SB(1, 1), cB + hstepB + kstep, voffB);
    PG8_WAIT_V(6); PG8_BAR;
    for (;;) {
        const bool has_next = S.next(ui + 1, nxt);
        const char* nA = has_next ? nxt.a : cA; const char* nB = has_next ? nxt.b : cB;
#pragma unroll 1
        for (int t = 0; t < nt; t += 2) {
            const bool last = (t == nt - 2);
            const char* a1 = cA + (size_t)(t + 1) * kstep;
            const char* a2 = last ? nA : cA + (size_t)(t + 2) * kstep; const char* b2 = last ? nB : cB + (size_t)(t + 2) * kstep;
            const char* a3 = a2 + kstep; const char* b3 = b2 + kstep;
            PG8_LDB(B0, 0, 0); PG8_LDB(B1, 0, 1); PG8_SCHED; PG8_LDA(At, 0, 0); PG8_STAGE(PG8_SA(1, 1), a1 + hstepA, voffA);
            PG8_WAIT_V(8); PG8_WAIT_L(0); PG8_BAR; PG8_MMA(0, 0, At, B0); PG8_MMA(0, 1, At, B1); PG8_BAR; PG8_SCHED;
            PG8_LDA(At, 0, 1); PG8_STAGE(PG8_SB(0, 0), b2, voffB); PG8_STAGE(PG8_SB(0, 1), b2 + hstepB, voffB); PG8_STAGE(PG8_SA(0, 0), a2, voffA);
            PG8_WAIT_V(8); PG8_WAIT_L(0); PG8_BAR; PG8_MMA(1, 0, At, B0); PG8_MMA(1, 1, At, B1); PG8_BAR; PG8_SCHED;
            PG8_LDB(B0, 1, 0); PG8_LDB(B1, 1, 1); PG8_SCHED; PG8_LDA(At, 1, 0); PG8_STAGE(PG8_SA(0, 1), a2 + hstepA, voffA);
            PG8_WAIT_V(8); PG8_WAIT_L(0); PG8_BAR; PG8_MMA(0, 0, At, B0); PG8_MMA(0, 1, At, B1); PG8_BAR; PG8_SCHED;
            PG8_LDA(At, 1, 1); PG8_STAGE(PG8_SB(1, 0), b3, voffB); PG8_STAGE(PG8_SB(1, 1), b3 + hstepB, voffB); PG8_STAGE(PG8_SA(1, 0), a3, voffA);
            PG8_WAIT_V(8); PG8_WAIT_L(0); PG8_BAR; PG8_MMA(1, 0, At, B0); PG8_MMA(1, 1, At, B1); PG8_BAR; PG8_SCHED;
        }
        if (wr == 0) PG8_BAR;
        const bool keep = E(acc, cur, wr, wc, fr, fq, xl);
        if (!has_next) break;
        if (!keep) {
#pragma unroll
            for (int a = 0; a < 2; ++a)
#pragma unroll
                for (int b = 0; b < 2; ++b)
#pragma unroll
                    for (int m = 0; m < 4; ++m)
#pragma unroll
                        for (int n = 0; n < 2; ++n) acc[a][b][m][n] = (f32x4){0.f, 0.f, 0.f, 0.f};
        }
        cur = nxt; cA = nA; cB = nB; ++ui;
        if (wr == 1) PG8_BAR;
    }
    PG8_WAIT_V(0);
    PG8_BAR;
#undef PG8_SA
#undef PG8_SB
#undef PG8_STAGE
#undef PG8_LDA
#undef PG8_LDB
#undef PG8_MMA
#undef PG8_WAIT_V
#undef PG8_WAIT_L
#undef PG8_BAR
#undef PG8_SCHED
}

#define EPI_GEOM int lo; asm volatile("v_mbcnt_lo_u32_b32 %0, -1, 0\n\tv_mbcnt_hi_u32_b32 %0, -1, %0" : "=v"(lo)); (void)fr; (void)fq; \
    const int fr_ = lo & 15, fq_ = lo >> 4; const int row0 = u.pm * 256 + wr * 64 + fr_, colw = wc * 32 + 8 * fq_
#define ACC8(v, ai, bj, m) float v[8] = {acc[ai][bj][m][0][0], acc[ai][bj][m][0][1], acc[ai][bj][m][0][2], acc[ai][bj][m][0][3], acc[ai][bj][m][1][0], acc[ai][bj][m][1][1], acc[ai][bj][m][1][2], acc[ai][bj][m][1][3]}

struct EpiProj {
    bf16_t* slots; const float* bmerge; bf16_t* kb; bf16_t* vt;
    __device__ __forceinline__ bool operator()(Acc& acc, const Unit& u, int wr, int wc, int fr, int fq, LAS unsigned char*) const {
        EPI_GEOM;
        bf16_t* base; int ldc, act = 0; const float* bias = nullptr;
        if (u.kind == 0) { const int seg = u.pn >> 2; base = slots + (size_t)seg * (SLOT / 2) + (u.pn & 3) * 256; ldc = 1024;
            act = (seg == 0) ? 1 : (seg >= 5 ? 2 : 0); if (seg >= 5) bias = bmerge + (seg - 5) * 1024 + (u.pn & 3) * 256; }
        else if (u.kind == 1) { base = kb + u.pn * 256; ldc = 1024; }
        else { base = vt + u.pn * 256; ldc = 1024; }
        if (u.kind == 0 && u.pn >= 12 && u.pn < 20) {
            bf16_t* pb = slots + (size_t)3 * (SLOT / 2) + (u.pn - 12) * 128 + colw;
#pragma unroll
            for (int ai = 0; ai < 2; ++ai)
#pragma unroll
                for (int m = 0; m < 4; ++m) { ACC8(vc, ai, 0, m); ACC8(vh, ai, 1, m);
#pragma unroll
                    for (int j = 0; j < 8; ++j) vc[j] *= vh[j];
                    *(u32x4*)(pb + (size_t)(row0 + ai * 128 + m * 16) * 1024) = pack8(vc); }
            return false;
        }
#pragma unroll
        for (int bj = 0; bj < 2; ++bj) {
            float bv[8];
#pragma unroll
            for (int j = 0; j < 8; ++j) bv[j] = 0.f;
            if (act == 2) { const f32x4 b0 = *(const f32x4*)(bias + colw + bj * 128), b1 = *(const f32x4*)(bias + colw + bj * 128 + 4);
#pragma unroll
                for (int j = 0; j < 4; ++j) { bv[j] = b0[j]; bv[4 + j] = b1[j]; } }
#pragma unroll
            for (int ai = 0; ai < 2; ++ai)
#pragma unroll
                for (int m = 0; m < 4; ++m) { ACC8(v, ai, bj, m);
                    if (act == 1) {
#pragma unroll
                        for (int j = 0; j < 8; ++j) v[j] = gelu_tanh(v[j]); }
                    else if (act == 2) {
#pragma unroll
                        for (int j = 0; j < 8; ++j) v[j] = sigmoidf_(v[j] + bv[j]); }
                    *(u32x4*)(base + (size_t)(row0 + ai * 128 + m * 16) * ldc + colw + bj * 128) = pack8(v); }
        }
        return false;
    }
};
struct EpiBf16 {
    bf16_t* out; int ldc; float scale;
    __device__ __forceinline__ bool operator()(Acc& acc, const Unit& u, int wr, int wc, int fr, int fq, LAS unsigned char*) const {
        EPI_GEOM;
#pragma unroll
        for (int ai = 0; ai < 2; ++ai)
#pragma unroll
            for (int m = 0; m < 4; ++m)
#pragma unroll
                for (int bj = 0; bj < 2; ++bj) { ACC8(v, ai, bj, m);
#pragma unroll
                    for (int j = 0; j < 8; ++j) v[j] *= scale;
                    *(u32x4*)(out + (size_t)(row0 + ai * 128 + m * 16) * ldc + u.pn * 256 + colw + bj * 128) = pack8(v); }
        return false;
    }
};
struct EpiGates {
    const bf16_t* ub; const float* br; const float* bi; const float* sp; unsigned short* la; unsigned short* bt;
    __device__ __forceinline__ bool operator()(Acc& acc, const Unit& u, int wr, int wc, int fr, int fq, LAS unsigned char*) const {
        EPI_GEOM;
#pragma unroll
        for (int n = 0; n < 2; ++n) { const int ch = u.pn * 128 + colw + 4 * n;
            const f32x4 vbr = *(const f32x4*)(br + ch), vbi = *(const f32x4*)(bi + ch), vsp = *(const f32x4*)(sp + ch);
            u32x2 uws[2][4];
#pragma unroll
            for (int ai = 0; ai < 2; ++ai)
#pragma unroll
                for (int m = 0; m < 4; ++m) uws[ai][m] = *(const u32x2*)(ub + (size_t)(row0 + ai * 128 + m * 16) * 1024 + ch);
#pragma unroll
            for (int ai = 0; ai < 2; ++ai)
#pragma unroll
                for (int m = 0; m < 4; ++m) { const int row = row0 + ai * 128 + m * 16; const bool first = (row & (SEQ - 1)) == 0;
                    const u32x2 uw = uws[ai][m]; const float uu[4] = {bf_lo(uw.x), bf_hi(uw.x), bf_lo(uw.y), bf_hi(uw.y)};
                    float l[4], b[4];
                    float yy[4], ig4[4];
#pragma unroll
                    for (int j = 0; j < 4; ++j) {
                        const float ea = __builtin_amdgcn_exp2f(fminf(-1.4426950408889634f * (acc[ai][0][m][n][j] + vbr[j]), 60.f)), eb = __builtin_amdgcn_exp2f(fminf(-1.4426950408889634f * (acc[ai][1][m][n][j] + vbi[j]), 60.f));
                        const float da = 1.0f + ea, db = 1.0f + eb, rr = __builtin_amdgcn_rcpf(da * db); const float r = rr * db; ig4[j] = rr * da; l[j] = vsp[j] * r; yy[j] = 2.0f * l[j]; }
                    const bool small = __builtin_amdgcn_ballot_w64(fminf(fminf(yy[0], yy[1]), fminf(yy[2], yy[3])) < -0.25f) == 0ull;
#pragma unroll
                    for (int j = 0; j < 4; ++j) { const float y = yy[j];
                        const float em = small ? -y * (1.0f + y * (0.5f + y * (0.16666667f + y * (0.041666668f + y * (0.0083333338f + y * (0.0013888889f + y * 0.0001984127f)))))) : 1.0f - __builtin_amdgcn_exp2f(1.4426950408889634f * y);
                        const float mult = first ? 1.0f : __builtin_amdgcn_sqrtf(em); b[j] = mult * ig4[j] * uu[j]; }
                    u32x2 wl, wb; wl.x = pack_h2(l[0], l[1]); wl.y = pack_h2(l[2], l[3]); wb.x = pack_h2(b[0], b[1]); wb.y = pack_h2(b[2], b[3]);
                    *(u32x2*)(la + (size_t)row * 1024 + ch) = wl; *(u32x2*)(bt + (size_t)row * 1024 + ch) = wb;
                    asm volatile("" ::: "memory"); }
        }
        return false;
    }
};
struct EpiMerge {
    const bf16_t* g1; const bf16_t* g2; bf16_t* out;
    __device__ __forceinline__ bool operator()(Acc& acc, const Unit& u, int wr, int wc, int fr, int fq, LAS unsigned char*) const {
        EPI_GEOM;
#pragma unroll
        for (int ai = 0; ai < 2; ++ai)
#pragma unroll
            for (int m = 0; m < 4; ++m)
#pragma unroll
                for (int bj = 0; bj < 2; ++bj) { const size_t off = (size_t)(row0 + ai * 128 + m * 16) * 1024 + u.pn * 256 + colw + bj * 128;
                    float b[8]; unpack8(*(const u32x4*)(g2 + off), b);
                    if (u.kind == 0) { float a[8]; unpack8(*(const u32x4*)(g1 + off), a);
#pragma unroll
                        for (int j = 0; j < 4; ++j) { acc[ai][bj][m][0][j] *= a[j] * __builtin_amdgcn_rcpf(b[j]); acc[ai][bj][m][1][j] *= a[4 + j] * __builtin_amdgcn_rcpf(b[4 + j]); } }
                    else { ACC8(v, ai, bj, m);
#pragma unroll
                        for (int j = 0; j < 8; ++j) v[j] *= b[j];
                        *(u32x4*)(out + off) = pack8(v); } }
        return u.kind == 0;
    }
};
struct EpiRes {
    const float* res; unsigned short* outh;
    __device__ __forceinline__ bool operator()(Acc& acc, const Unit& u, int wr, int wc, int fr, int fq, LAS unsigned char*) const {
        EPI_GEOM;
#pragma unroll
        for (int ai = 0; ai < 2; ++ai)
#pragma unroll
            for (int bj = 0; bj < 2; ++bj) { const size_t off0 = (size_t)(row0 + ai * 128) * 1024 + u.pn * 256 + colw + bj * 128;
                f32x4 r0[4], r1[4];
#pragma unroll
                for (int m = 0; m < 4; ++m) { r0[m] = __builtin_nontemporal_load((const f32x4*)(res + off0 + (size_t)m * 16 * 1024)); r1[m] = __builtin_nontemporal_load((const f32x4*)(res + off0 + (size_t)m * 16 * 1024 + 4)); }
#pragma unroll
                for (int m = 0; m < 4; ++m) { const f32x4 t0 = r0[m] * ALPHA + acc[ai][bj][m][0], t1 = r1[m] * ALPHA + acc[ai][bj][m][1];
                    u32x4 w; w.x = pack_h2(t0[0], t0[1]); w.y = pack_h2(t0[2], t0[3]); w.z = pack_h2(t1[0], t1[1]); w.w = pack_h2(t1[2], t1[3]);
                    *(u32x4*)(outh + off0 + (size_t)m * 16 * 1024) = w; }
                asm volatile("" ::: "memory"); }
        return false;
    }
};
struct EpiResB {
    const bf16_t* resb; unsigned short* outh;
    __device__ __forceinline__ bool operator()(Acc& acc, const Unit& u, int wr, int wc, int fr, int fq, LAS unsigned char*) const {
        EPI_GEOM;
#pragma unroll
        for (int ai = 0; ai < 2; ++ai) { const size_t off0 = (size_t)(row0 + ai * 128) * 1024 + u.pn * 256 + colw;
            u32x4 rb[4][2];
#pragma unroll
            for (int m = 0; m < 4; ++m)
#pragma unroll
                for (int bj = 0; bj < 2; ++bj) rb[m][bj] = *(const u32x4*)(resb + off0 + (size_t)m * 16 * 1024 + bj * 128);
#pragma unroll
            for (int m = 0; m < 4; ++m)
#pragma unroll
                for (int bj = 0; bj < 2; ++bj) { float r[8]; unpack8(rb[m][bj], r);
                    const f32x4 t0 = (f32x4){r[0], r[1], r[2], r[3]} * ALPHA + acc[ai][bj][m][0], t1 = (f32x4){r[4], r[5], r[6], r[7]} * ALPHA + acc[ai][bj][m][1];
                    u32x4 w; w.x = pack_h2(t0[0], t0[1]); w.y = pack_h2(t0[2], t0[3]); w.z = pack_h2(t1[0], t1[1]); w.w = pack_h2(t1[2], t1[3]);
                    *(u32x4*)(outh + off0 + (size_t)m * 16 * 1024 + bj * 128) = w; }
            asm volatile("" ::: "memory"); }
        return false;
    }
};
struct EpiScore {
    bf16_t* P; float* rs;
    __device__ __forceinline__ bool operator()(Acc& acc, const Unit& u, int wr, int wc, int fr, int fq, LAS unsigned char* xl) const {
        EPI_GEOM; LAS float* mx = (LAS float*)xl;
#pragma unroll
        for (int ai = 0; ai < 2; ++ai)
#pragma unroll
            for (int m = 0; m < 4; ++m) { float mv = -3.0e38f;
#pragma unroll
                for (int bj = 0; bj < 2; ++bj)
#pragma unroll
                    for (int n = 0; n < 2; ++n)
#pragma unroll
                        for (int j = 0; j < 4; ++j) mv = fmaxf(mv, acc[ai][bj][m][n][j]);
                mv = fmaxf(mv, bperm_xor(mv, lo, 16)); mv = fmaxf(mv, bperm_xor(mv, lo, 32));
                if (fq_ == 0) mx[(ai * 128 + wr * 64 + m * 16 + fr_) * 4 + wc] = mv; }
        asm volatile("s_waitcnt lgkmcnt(0)" ::: "memory"); __builtin_amdgcn_s_barrier(); asm volatile("" ::: "memory");
#pragma unroll
        for (int ai = 0; ai < 2; ++ai)
#pragma unroll
            for (int m = 0; m < 4; ++m) { const int rl = ai * 128 + wr * 64 + m * 16 + fr_; const f32x4 q = *(const LAS f32x4*)(mx + rl * 4);
                const float mv = fmaxf(fmaxf(q[0], q[1]), fmaxf(q[2], q[3])) * 1.4426950408889634f; float sum = 0.f;
#pragma unroll
                for (int bj = 0; bj < 2; ++bj) { ACC8(v, ai, bj, m);
#pragma unroll
                    for (int j = 0; j < 8; ++j) v[j] = __builtin_amdgcn_exp2f(v[j] * 1.4426950408889634f - mv);
                    const u32x4 w = pack8(v); float r[8]; unpack8(w, r);
#pragma unroll
                    for (int j = 0; j < 8; ++j) sum += r[j];
                    *(u32x4*)(P + (size_t)(row0 + ai * 128 + m * 16) * 1024 + u.pn * 256 + colw + bj * 128) = w; }
                sum += bperm_xor(sum, lo, 16); sum += bperm_xor(sum, lo, 32);
                if (fq_ == 0) rs[((size_t)u.pn * MT + (row0 + ai * 128 + m * 16)) * 4 + wc] = sum;
                asm volatile("" ::: "memory"); }
        return false;
    }
};

struct SchedPre {
    int G, c; const char* kb; const char* wq; const char* wxo; const char* vb;
    __device__ __forceinline__ bool next(int i, Unit& u) const {
        const int L = i * G + c; if (L >= 128) return false;
        const int t = L & 63, b = t >> 4, h = (t >> 2) & 3, nt = t & 3; const size_t ts = (size_t)256 * 1024 * 2;
        u.kind = L >> 6; u.pm = (b << 2) | h; u.pn = nt;
        if (u.kind == 0) { u.a = kb + (size_t)b * ts + h * 512; u.b = wq + (size_t)nt * ts + h * 512; }
        else { u.a = wxo + (size_t)nt * ts + h * 512; u.b = vb + (size_t)b * ts + h * 512; }
        return true; }
};
struct EpiPre {
    bf16_t* gb; bf16_t* vwb;
    __device__ __forceinline__ bool operator()(Acc& acc, const Unit& u, int wr, int wc, int fr, int fq, LAS unsigned char*) const {
        EPI_GEOM; const int b = u.pm >> 2, h = u.pm & 3;
        bf16_t* base = (u.kind == 0) ? gb + (size_t)u.pm * 256 * 1024 + u.pn * 256 : vwb + (size_t)b * 1024 * 1024 + (size_t)u.pn * 256 * 1024 + h * 256;
        const float scale = (u.kind == 0) ? 0.0625f : 1.0f; const int rl0 = wr * 64 + fr_;
#pragma unroll
        for (int ai = 0; ai < 2; ++ai)
#pragma unroll
            for (int m = 0; m < 4; ++m)
#pragma unroll
                for (int bj = 0; bj < 2; ++bj) { ACC8(v, ai, bj, m);
#pragma unroll
                    for (int j = 0; j < 8; ++j) v[j] *= scale;
                    *(u32x4*)(base + (size_t)(rl0 + ai * 128 + m * 16) * 1024 + colw + bj * 128) = pack8(v); }
        (void)row0;
        return false;
    }
};
struct EpiScoreN {
    bf16_t* P;
    __device__ __forceinline__ bool operator()(Acc& acc, const Unit& u, int wr, int wc, int fr, int fq, LAS unsigned char* xl) const {
        EPI_GEOM; LAS float* mx = (LAS float*)xl; LAS float* sx = (LAS float*)(xl + 4096);
#pragma unroll
        for (int ai = 0; ai < 2; ++ai)
#pragma unroll
            for (int m = 0; m < 4; ++m) { float mv = -3.0e38f;
#pragma unroll
                for (int bj = 0; bj < 2; ++bj)
#pragma unroll
                    for (int n = 0; n < 2; ++n)
#pragma unroll
                        for (int j = 0; j < 4; ++j) mv = fmaxf(mv, acc[ai][bj][m][n][j]);
                mv = fmaxf(mv, bperm_xor(mv, lo, 16)); mv = fmaxf(mv, bperm_xor(mv, lo, 32));
                if (fq_ == 0) mx[(ai * 128 + wr * 64 + m * 16 + fr_) * 4 + wc] = mv; }
        asm volatile("s_waitcnt lgkmcnt(0)" ::: "memory"); __builtin_amdgcn_s_barrier(); asm volatile("" ::: "memory");
#pragma unroll
        for (int ai = 0; ai < 2; ++ai)
#pragma unroll
            for (int m = 0; m < 4; ++m) { const int rl = ai * 128 + wr * 64 + m * 16 + fr_; const f32x4 q = *(const LAS f32x4*)(mx + rl * 4);
                const float mv = fmaxf(fmaxf(q[0], q[1]), fmaxf(q[2], q[3])) * 1.4426950408889634f; float sum = 0.f;
#pragma unroll
                for (int bj = 0; bj < 2; ++bj)
#pragma unroll
                    for (int n = 0; n < 2; ++n)
#pragma unroll
                        for (int j = 0; j < 4; ++j) { const float e = __builtin_amdgcn_exp2f(acc[ai][bj][m][n][j] * 1.4426950408889634f - mv); acc[ai][bj][m][n][j] = e; sum += e; }
                sum += bperm_xor(sum, lo, 16); sum += bperm_xor(sum, lo, 32);
                if (fq_ == 0) sx[rl * 4 + wc] = sum; }
        asm volatile("s_waitcnt lgkmcnt(0)" ::: "memory"); __builtin_amdgcn_s_barrier(); asm volatile("" ::: "memory");
#pragma unroll
        for (int ai = 0; ai < 2; ++ai)
#pragma unroll
            for (int m = 0; m < 4; ++m) { const int rl = ai * 128 + wr * 64 + m * 16 + fr_; const f32x4 q = *(const LAS f32x4*)(sx + rl * 4);
                const float inv = __builtin_amdgcn_rcpf((q[0] + q[1]) + (q[2] + q[3]));
#pragma unroll
                for (int bj = 0; bj < 2; ++bj) { ACC8(v, ai, bj, m);
#pragma unroll
                    for (int j = 0; j < 8; ++j) v[j] *= inv;
                    *(u32x4*)(P + (size_t)(row0 + ai * 128 + m * 16) * 1024 + u.pn * 256 + colw + bj * 128) = pack8(v); }
                asm volatile("" ::: "memory"); }
        return false;
    }
};

struct SchedKVS {
    int G, c; const char* memb; const char* wk; const char* wv;
    __device__ __forceinline__ bool next(int i, Unit& u) const {
        const int L = i * G + c; if (L >= 128) return false;
        const int mat = L >> 6, rt = (L >> 4) & 3, ct = (L >> 2) & 3, ks = L & 3; const size_t ts = (size_t)256 * 1024 * 2;
        u.kind = mat * 4 + ks; u.pm = rt; u.pn = ct; u.a = memb + (size_t)rt * ts + ks * 512; u.b = (mat ? wv : wk) + (size_t)ct * ts + ks * 512; return true; }
};
struct EpiPart {
    float* part;
    __device__ __forceinline__ bool operator()(Acc& acc, const Unit& u, int wr, int wc, int fr, int fq, LAS unsigned char*) const {
        EPI_GEOM; float* base = part + (size_t)u.kind * 1024 * 1024;
#pragma unroll
        for (int ai = 0; ai < 2; ++ai)
#pragma unroll
            for (int m = 0; m < 4; ++m)
#pragma unroll
                for (int bj = 0; bj < 2; ++bj) { float* q = base + (size_t)(row0 + ai * 128 + m * 16) * 1024 + u.pn * 256 + colw + bj * 128;
                    *(f32x4*)q = acc[ai][bj][m][0]; *(f32x4*)(q + 4) = acc[ai][bj][m][1]; }
        return false;
    }
};
struct EpiPV {
    const float* rs; bf16_t* out;
    __device__ __forceinline__ bool operator()(Acc& acc, const Unit& u, int wr, int wc, int fr, int fq, LAS unsigned char*) const {
        EPI_GEOM;
#pragma unroll
        for (int ai = 0; ai < 2; ++ai)
#pragma unroll
            for (int m = 0; m < 4; ++m) { const int row = row0 + ai * 128 + m * 16; const f32x4 q = *(const f32x4*)(rs + ((size_t)u.pn * MT + row) * 4);
                const float inv = 1.0f / ((q[0] + q[1]) + (q[2] + q[3]));
#pragma unroll
                for (int bj = 0; bj < 2; ++bj) { ACC8(v, ai, bj, m);
#pragma unroll
                    for (int j = 0; j < 8; ++j) v[j] *= inv;
                    *(u32x4*)(out + (size_t)row * 1024 + u.pn * 256 + colw + bj * 128) = pack8(v); } }
        return false;
    }
};
__device__ __forceinline__ unsigned ror_row(unsigned v, const int n) { return (unsigned)(n == 1 ? __builtin_amdgcn_update_dpp(0, (int)v, 0x121, 0xf, 0xf, false) : __builtin_amdgcn_update_dpp(0, (int)v, 0x122, 0xf, 0xf, false)); }
struct EpiFfnUp {
    const bf16_t* g; const float* cw; const float* cb; bf16_t* out;
    __device__ __forceinline__ bool operator()(Acc& acc, const Unit& u, int wr, int wc, int fr, int fq, LAS unsigned char*) const {
        EPI_GEOM;
#pragma unroll
        for (int bj = 0; bj < 2; ++bj) { const int col = u.pn * 256 + colw + bj * 128;
            float w0[8], w1[8], w2[8], bb[8];
            { const f32x4 a0 = *(const f32x4*)(cw + col), a1 = *(const f32x4*)(cw + col + 4), b0 = *(const f32x4*)(cw + DFF + col), b1 = *(const f32x4*)(cw + DFF + col + 4),
                          c0 = *(const f32x4*)(cw + 2 * DFF + col), c1 = *(const f32x4*)(cw + 2 * DFF + col + 4), d0 = *(const f32x4*)(cb + col), d1 = *(const f32x4*)(cb + col + 4);
#pragma unroll
              for (int j = 0; j < 4; ++j) { w0[j] = a0[j]; w0[4 + j] = a1[j]; w1[j] = b0[j]; w1[4 + j] = b1[j]; w2[j] = c0[j]; w2[4 + j] = c1[j]; bb[j] = d0[j]; bb[4 + j] = d1[j]; } }
#pragma unroll
            for (int ai = 0; ai < 2; ++ai) { const int R = u.pm * 256 + ai * 128 + wr * 64;
                u32x4 G0[4], H1 = (u32x4){0u, 0u, 0u, 0u}, H2 = (u32x4){0u, 0u, 0u, 0u};
#pragma unroll
                for (int m = 0; m < 4; ++m) G0[m] = *(const u32x4*)(g + (size_t)(R + m * 16 + fr_) * DFF + col);
                if ((R & (SEQ - 1)) != 0) { H1 = *(const u32x4*)(g + (size_t)(R - 1) * DFF + col); H2 = *(const u32x4*)(g + (size_t)(R - 2) * DFF + col); }
                u32x4 prev;
#pragma unroll
                for (int j = 0; j < 4; ++j) prev[j] = (fr_ == 15) ? H1[j] : H2[j];
#pragma unroll
                for (int m = 0; m < 4; ++m) { const int row = row0 + ai * 128 + m * 16; const u32x4 cur = G0[m]; u32x4 t1, t2;
#pragma unroll
                    for (int j = 0; j < 4; ++j) { const unsigned c1r = ror_row(cur[j], 1), p1r = ror_row(prev[j], 1), c2r = ror_row(cur[j], 2), p2r = ror_row(prev[j], 2);
                        t1[j] = (fr_ == 0) ? p1r : c1r; t2[j] = (fr_ < 2) ? p2r : c2r; }
                    float g0[8], g1[8], g2[8]; unpack8(cur, g0); unpack8(t1, g1); unpack8(t2, g2);
                    ACC8(v, ai, bj, m);
#pragma unroll
                    for (int j = 0; j < 8; ++j) { const float gate = w0[j] * g0[j] + w1[j] * g1[j] + w2[j] * g2[j] + bb[j]; v[j] *= gelu_tanh(gate); }
                    *(u32x4*)(out + (size_t)row * DFF + col) = pack8(v);
                    prev = cur; }
                asm volatile("" ::: "memory");
            }
        }
        return false;
    }
};

struct Params { const float* in[30]; float* out; unsigned char* ws; };

__device__ __forceinline__ void transpose_cvt(const float* __restrict__ src, bf16_t* __restrict__ dst, int K, int N, LAS float* tiles, int& job, const bool pair_sc = false) {
    const int tid = tid_opaque(), lane = tid & 63, wv = tid >> 6, tk = K / 64, tn = N / 64, ntile = tk * tn, nwv = (int)gridDim.x * 8, me = (int)blockIdx.x * 8 + wv;
    LAS float* tile = tiles + wv * (64 * 65);
    const int first = ((me - (job % nwv)) % nwv + nwv) % nwv;
    job += ntile;
    for (int t = first; t < ntile; t += nwv) {
        const int k0 = (t / tn) * 64, n0 = (t % tn) * 64;
        int nd = n0; if (pair_sc && n0 >= 3072 && n0 < 5120) { const int sg = (n0 - 3072) >> 10, ch = (n0 - 3072) & 1023; nd = 3072 + (ch >> 7) * 256 + sg * 128 + (ch & 127); }
        f32x4 v[16];
#pragma unroll
        for (int it = 0; it < 16; ++it) v[it] = __builtin_nontemporal_load((const f32x4*)(src + (size_t)(k0 + it * 4 + (lane >> 4)) * N + n0 + (lane & 15) * 4));
#pragma unroll
        for (int it = 0; it < 16; ++it) { const int r = it * 4 + (lane >> 4), c4 = (lane & 15) * 4;
            tile[r * 65 + c4 + 0] = v[it][0]; tile[r * 65 + c4 + 1] = v[it][1]; tile[r * 65 + c4 + 2] = v[it][2]; tile[r * 65 + c4 + 3] = v[it][3]; }
        asm volatile("s_waitcnt lgkmcnt(0)" ::: "memory");
#pragma unroll
        for (int it = 0; it < 8; ++it) { const int n = it * 8 + (lane >> 3), k8 = (lane & 7) * 8; float f[8];
#pragma unroll
            for (int q = 0; q < 8; ++q) f[q] = tile[(k8 + q) * 65 + n];
            *(u32x4*)(dst + (size_t)(nd + n) * K + k0 + k8) = pack8(f); }
        asm volatile("s_waitcnt lgkmcnt(0)" ::: "memory");
    }
}
__device__ __forceinline__ void cvt_rows(const float* __restrict__ src, bf16_t* __restrict__ dst, size_t n8) {
    const size_t G_ = gridDim.x, per0 = (n8 + G_ - 1) / G_, base = (size_t)vblk() * per0, per = base >= n8 ? 0 : (n8 - base < per0 ? n8 - base : per0);
    for (size_t i = tid_opaque(); i < per; i += 4 * 512) { f32x4 a[4], b[4];
#pragma unroll
        for (int q = 0; q < 4; ++q) { const size_t e = i + q * 512; if (e < per) { a[q] = __builtin_nontemporal_load((const f32x4*)(src + (base + e) * 8)); b[q] = __builtin_nontemporal_load((const f32x4*)(src + (base + e) * 8 + 4)); } }
#pragma unroll
        for (int q = 0; q < 4; ++q) { const size_t e = i + q * 512; if (e < per) { float f[8] = {a[q][0], a[q][1], a[q][2], a[q][3], b[q][0], b[q][1], b[q][2], b[q][3]}; *(u32x4*)(dst + (base + e) * 8) = pack8(f); } } }
}
__device__ __forceinline__ void phase_prep(const Params& p, LAS unsigned char* lds) {
    unsigned char* ws = p.ws; LAS float* tile = (LAS float*)lds; int job = 0;
    cvt_rows(p.in[0], (bf16_t*)p.out, (size_t)MT * DM / 8);
    cvt_rows(p.in[1], (bf16_t*)(ws + WS_MEMB), (size_t)1024 * DM / 8);
    transpose_cvt(p.in[2], (bf16_t*)(ws + WS_WIN), 1024, 7168, tile, job, true);
    transpose_cvt(p.in[10], (bf16_t*)(ws + WS_WLRU), 1024, 1024, tile, job);
    transpose_cvt(p.in[12], (bf16_t*)(ws + WS_WSC), 1024, 1024, tile, job);
    transpose_cvt(p.in[14], (bf16_t*)(ws + WS_WMIX), 1024, 1024, tile, job);
    cvt_rows(p.in[17], (bf16_t*)(ws + WS_WQ), (size_t)1024 * 1024 / 8);
    transpose_cvt(p.in[18], (bf16_t*)(ws + WS_WK), 1024, 1024, tile, job);
    transpose_cvt(p.in[19], (bf16_t*)(ws + WS_WV), 1024, 1024, tile, job);
    transpose_cvt(p.in[20], (bf16_t*)(ws + WS_WXO), 1024, 1024, tile, job);
    transpose_cvt(p.in[23], (bf16_t*)(ws + WS_WFG), 1024, 3072, tile, job);
    transpose_cvt(p.in[24], (bf16_t*)(ws + WS_WFU), 1024, 3072, tile, job);
    transpose_cvt(p.in[27], (bf16_t*)(ws + WS_WFD), 3072, 1024, tile, job);
    { const float* wr_ = p.in[5]; const float* wi_ = p.in[7]; bf16_t* wg = (bf16_t*)(ws + WS_WG);
      for (int i = blockIdx.x * 512 + tid_opaque(); i < 2048 * 256; i += gridDim.x * 512) { const int kk = i & 255, rowj = i >> 8, h = rowj >> 8, j = rowj & 255, ii = kk - 128 * (h & 1);
          float v = 0.f; if (ii >= 0 && ii < 128) v = (j < 128) ? wr_[(h * 128 + ii) * 128 + j] : wi_[(h * 128 + ii) * 128 + (j - 128)];
          wg[i] = (bf16_t)(cvt_pk_bf16(v, 0.f) & 0xffffu); } }
    { float* sp = (float*)(ws + WS_SP); const float* lam = p.in[9];
      for (int i = blockIdx.x * 512 + tid_opaque(); i < 1024; i += gridDim.x * 512) { const float x = -lam[i]; const float spl = (x > 20.f) ? x : log1pf(expf(x)); sp[i] = -8.0f * spl; } }
}
__device__ __forceinline__ void phase_conv(const Params& p) {
    const bf16_t* PL = (const bf16_t*)(p.ws + WS_SLOT + 1 * SLOT); const bf16_t* PB = (const bf16_t*)(p.ws + WS_SLOT + 2 * SLOT);
    const bf16_t* PP = (const bf16_t*)(p.ws + WS_SLOT + 3 * SLOT);
    bf16_t* S_ = (bf16_t*)p.out; bf16_t* U_ = (bf16_t*)((unsigned char*)p.out + SLOT);
    const float* lw = p.in[3]; const float* lb = p.in[4]; const float* sw = p.in[11];
    for (int idx = vblk() * 512 + tid_opaque(); idx < 1024 * 128; idx += gridDim.x * 512) {
        const int c = (idx & 127) * 8, row0 = (idx >> 7) * 32;
        float w0[8], w1[8], w2[8], w3[8], bb[8], s0[8], s1[8], s2[8];
#pragma unroll
        for (int j = 0; j < 8; ++j) { w0[j] = lw[c + j]; w1[j] = lw[1024 + c + j]; w2[j] = lw[2048 + c + j]; w3[j] = lw[3072 + c + j]; bb[j] = lb[c + j]; s0[j] = sw[c + j]; s1[j] = sw[1024 + c + j]; s2[j] = sw[2048 + c + j]; }
        float l1[8], l2[8], l3[8], p1[8], p2[8];
        if ((row0 & (SEQ - 1)) != 0) { const size_t o = (size_t)row0 * 1024 + c;
            unpack8(*(const u32x4*)(PL + o - 1024), l1); unpack8(*(const u32x4*)(PL + o - 2048), l2); unpack8(*(const u32x4*)(PL + o - 3072), l3);
            unpack8(*(const u32x4*)(PP + o - 1024), p1); unpack8(*(const u32x4*)(PP + o - 2048), p2);
        } else {
#pragma unroll
            for (int j = 0; j < 8; ++j) { l1[j] = 0.f; l2[j] = 0.f; l3[j] = 0.f; p1[j] = 0.f; p2[j] = 0.f; } }
#pragma unroll 4
        for (int t = 0; t < 32; ++t) { const size_t o = (size_t)(row0 + t) * 1024 + c;
            float l0[8], vb[8], vp[8]; unpack8(__builtin_nontemporal_load((const u32x4*)(PL + o)), l0); unpack8(__builtin_nontemporal_load((const u32x4*)(PB + o)), vb); unpack8(__builtin_nontemporal_load((const u32x4*)(PP + o)), vp);
            float uo[8], so[8];
#pragma unroll
            for (int j = 0; j < 8; ++j) { uo[j] = w0[j] * l0[j] + w1[j] * l1[j] + w2[j] * l2[j] + w3[j] * l3[j] + bb[j];
                const float p0 = vp[j]; so[j] = vb[j] * (s0[j] * p0 + s1[j] * p1[j] + s2[j] * p2[j]);
                l3[j] = l2[j]; l2[j] = l1[j]; l1[j] = l0[j]; p2[j] = p1[j]; p1[j] = p0; }
            *(u32x4*)(U_ + o) = pack8(uo); *(u32x4*)(S_ + o) = pack8(so); }
    }
}
__device__ __forceinline__ void phase_scan1(const Params& p) {
    const unsigned* LA = (const unsigned*)(p.ws + WS_SLOT + 1 * SLOT); const unsigned* BT = (const unsigned*)(p.ws + WS_SLOT + 2 * SLOT);
    f32x2* AGA = (f32x2*)(p.ws + WS_AGG); f32x2* AGH = (f32x2*)(p.ws + WS_AGG + MiB);
    for (int idx = vblk() * 512 + tid_opaque(); idx < 256 * 512; idx += gridDim.x * 512) {
        const int cp = idx & 511, ck = idx >> 9; const size_t o0 = (size_t)ck * 128 * 512 + cp;
        f32x2 h = (f32x2){0.f, 0.f}, ls = (f32x2){0.f, 0.f};
#pragma unroll 16
        for (int t = 0; t < 128; ++t) { const f32x2 l = unpack_h2(LA[o0 + (size_t)t * 512]), b = unpack_h2(BT[o0 + (size_t)t * 512]);
            ls += l; h.x = __builtin_amdgcn_exp2f(l.x * 1.4426950408889634f) * h.x + b.x; h.y = __builtin_amdgcn_exp2f(l.y * 1.4426950408889634f) * h.y + b.y; }
        AGA[idx] = ls; AGH[idx] = h;
    }
}
__device__ __forceinline__ void phase_scan3(const Params& p) {
    const unsigned* LA = (const unsigned*)(p.ws + WS_SLOT + 1 * SLOT); const unsigned* BT = (const unsigned*)(p.ws + WS_SLOT + 2 * SLOT);
    const unsigned* PG = (const unsigned*)(p.ws + WS_SLOT + 0 * SLOT); unsigned* YL = (unsigned*)(p.ws + WS_SLOT + 3 * SLOT);
    const f32x2* AGA = (const f32x2*)(p.ws + WS_AGG); const f32x2* AGH = (const f32x2*)(p.ws + WS_AGG + MiB);
    for (int idx = vblk() * 512 + tid_opaque(); idx < 256 * 512; idx += gridDim.x * 512) {
        const int cp = idx & 511, ck = idx >> 9, ckb = ck & ~63; const size_t o0 = (size_t)ck * 128 * 512 + cp;
        f32x2 h = (f32x2){0.f, 0.f};
#pragma unroll 8
        for (int j = ckb; j < ck; ++j) { const f32x2 a = AGA[j * 512 + cp], hh = AGH[j * 512 + cp];
            h.x = __builtin_amdgcn_exp2f(a.x * 1.4426950408889634f) * h.x + hh.x; h.y = __builtin_amdgcn_exp2f(a.y * 1.4426950408889634f) * h.y + hh.y; }
#pragma unroll 16
        for (int t = 0; t < 128; ++t) { const size_t o = o0 + (size_t)t * 512; const f32x2 l = unpack_h2(__builtin_nontemporal_load(LA + o)), b = unpack_h2(__builtin_nontemporal_load(BT + o)); const unsigned gw = __builtin_nontemporal_load(PG + o);
            h.x = __builtin_amdgcn_exp2f(l.x * 1.4426950408889634f) * h.x + b.x; h.y = __builtin_amdgcn_exp2f(l.y * 1.4426950408889634f) * h.y + b.y;
            YL[o] = cvt_pk_bf16(bf_lo(gw) * h.x, bf_hi(gw) * h.y); }
    }
}
__device__ __forceinline__ void phase_ln(const unsigned short* xh, const float* g, const float* b, bf16_t* xb, float* xf) {
    const int tid = tid_opaque(); const int lane = tid & 63, nw = gridDim.x * 8, rpw = (MT + nw - 1) / nw, wv = vblk() * 8 + (tid >> 6);
    float gv[2][8], bv[2][8];
#pragma unroll
    for (int j = 0; j < 2; ++j) { const f32x4 g0 = *(const f32x4*)(g + j * 512 + lane * 8), g1 = *(const f32x4*)(g + j * 512 + lane * 8 + 4), b0 = *(const f32x4*)(b + j * 512 + lane * 8), b1 = *(const f32x4*)(b + j * 512 + lane * 8 + 4);
#pragma unroll
        for (int e = 0; e < 4; ++e) { gv[j][e] = g0[e]; gv[j][4 + e] = g1[e]; bv[j][e] = b0[e]; bv[j][4 + e] = b1[e]; } }
    const int rend = ((wv + 1) * rpw < MT) ? (wv + 1) * rpw : MT;
    for (int rowa = wv * rpw; rowa < rend; rowa += 2) {
        const int rowb = (rowa + 1 < rend) ? rowa + 1 : rowa; const bool hb = rowa + 1 < rend;
        float v[2][2][8];
#pragma unroll
        for (int r = 0; r < 2; ++r)
#pragma unroll
            for (int j = 0; j < 2; ++j) { const u32x4 w = __builtin_nontemporal_load((const u32x4*)(xh + (size_t)(r ? rowb : rowa) * 1024 + j * 512 + lane * 8));
                const f32x2 p0 = unpack_h2(w.x), p1 = unpack_h2(w.y), p2 = unpack_h2(w.z), p3 = unpack_h2(w.w);
                v[r][j][0] = p0.x; v[r][j][1] = p0.y; v[r][j][2] = p1.x; v[r][j][3] = p1.y; v[r][j][4] = p2.x; v[r][j][5] = p2.y; v[r][j][6] = p3.x; v[r][j][7] = p3.y; }
        float s[2] = {0.f, 0.f}, q[2] = {0.f, 0.f};
#pragma unroll
        for (int r = 0; r < 2; ++r)
#pragma unroll
            for (int j = 0; j < 2; ++j)
#pragma unroll
                for (int e = 0; e < 8; ++e) s[r] += v[r][j][e];
#pragma unroll
        for (int o = 32; o >= 1; o >>= 1) { s[0] += __shfl_xor(s[0], o); s[1] += __shfl_xor(s[1], o); }
#pragma unroll
        for (int r = 0; r < 2; ++r) { const float mean = s[r] * (1.0f / 1024.0f);
#pragma unroll
            for (int j = 0; j < 2; ++j)
#pragma unroll
                for (int e = 0; e < 8; ++e) { v[r][j][e] -= mean; q[r] += v[r][j][e] * v[r][j][e]; } }
#pragma unroll
        for (int o = 32; o >= 1; o >>= 1) { q[0] += __shfl_xor(q[0], o); q[1] += __shfl_xor(q[1], o); }
#pragma unroll
        for (int r = 0; r < 2; ++r) { if (r == 1 && !hb) break; const int row = r ? rowb : rowa; const float rstd2 = 1.0f / __builtin_sqrtf(q[r] * (1.0f / 1024.0f) + LN_EPS);
#pragma unroll
            for (int j = 0; j < 2; ++j) { float y[8];
#pragma unroll
                for (int e = 0; e < 8; ++e) y[e] = v[r][j][e] * rstd2 * gv[j][e] + bv[j][e];
                const size_t off = (size_t)row * 1024 + j * 512 + lane * 8;
                if (xb) *(u32x4*)(xb + off) = pack8(y);
                if (xf) { *(f32x4*)(xf + off) = (f32x4){y[0], y[1], y[2], y[3]}; *(f32x4*)(xf + off + 4) = (f32x4){y[4], y[5], y[6], y[7]}; } } }
    }
}


#define XB_TMO      128
#define XB_XCNT(j)  (256  + 64 * (j))
#define XB_XSUB(j)  (1280 + 64 * (j))
#define XB_XGEN(j)  (2304 + 64 * (j))
#define XB_TOP      3328
#define XB_TOPGEN   3392
#define XCD_BAR_WORDS 3456
#define XB_SPIN_CAP (1u << 18)
__device__ __forceinline__ unsigned xb_ld(unsigned* p)              { return __hip_atomic_load(p, __ATOMIC_RELAXED, __HIP_MEMORY_SCOPE_AGENT); }
__device__ __forceinline__ unsigned xb_add(unsigned* p, unsigned v) { return __hip_atomic_fetch_add(p, v, __ATOMIC_RELAXED, __HIP_MEMORY_SCOPE_AGENT); }
__device__ __forceinline__ unsigned xb_xcc_id() { return (unsigned)__builtin_amdgcn_s_getreg((3 << 11) | 20) & 0xFu; }
#define XB_SPIN(cond, bar) do { unsigned _sp = 0; while (cond) { __builtin_amdgcn_s_sleep(1); \
    if ((++_sp & 255u) == 0u) { if (xb_ld(&(bar)[XB_TMO])) break; if (_sp > XB_SPIN_CAP) { atomicAdd(&(bar)[XB_TMO], 1u); break; } } } } while (0)
struct XcdBarrier { unsigned* bar; unsigned x; volatile LAS unsigned* st; };
__device__ __forceinline__ XcdBarrier xcd_barrier_post(unsigned* bar, volatile LAS unsigned* st) {
    XcdBarrier b; b.bar = bar; b.x = xb_xcc_id(); b.st = st;
    if (threadIdx.x == 0) (void)xb_add(&bar[XB_XCNT(b.x)], 1u);
    return b;
}
__device__ __forceinline__ void xcd_barrier_complete(unsigned* bar, unsigned x, unsigned& nloc, unsigned& nx) {
    const unsigned G = gridDim.x * gridDim.y * gridDim.z;
    unsigned sum, cnt, mine, sp = 0u;
    for (;;) {
        sum = 0u; cnt = 0u; mine = 0u;
#pragma unroll
        for (unsigned j = 0; j < 16; ++j) { const unsigned c = xb_ld(&bar[XB_XCNT(j)]); sum += c; cnt += (c > 0u) ? 1u : 0u; mine = (j == x) ? c : mine; }
        if (sum == G) break;
        __builtin_amdgcn_s_sleep(1);
        if ((++sp & 255u) == 0u) { if (xb_ld(&bar[XB_TMO])) break; if (sp > XB_SPIN_CAP) { atomicAdd(&bar[XB_TMO], 1u); break; } }
    }
    nloc = mine > 0u ? mine : 1u; nx = cnt > 0u ? cnt : 1u;
}
__device__ __forceinline__ void xcd_barrier(const XcdBarrier& b) {
    asm volatile("s_waitcnt vmcnt(0)" ::: "memory");
    __syncthreads();
    if (threadIdx.x == 0) {
        unsigned* bar = b.bar;
        __builtin_amdgcn_s_waitcnt(0);
        unsigned nloc = b.st[0], nx = b.st[1];
        if (nloc == 0u) { xcd_barrier_complete(bar, b.x, nloc, nx); b.st[0] = nloc; b.st[1] = nx; }
        const unsigned old = xb_add(&bar[XB_XSUB(b.x)], 1u);
        const unsigned gen = old / nloc;
        if (old + 1u == (gen + 1u) * nloc) {
            __builtin_amdgcn_fence(__ATOMIC_RELEASE, "agent");
            asm volatile("s_waitcnt vmcnt(0)" ::: "memory");
            const unsigned og = xb_add(&bar[XB_TOP], 1u);
            const unsigned tg = og / nx;
            if (og + 1u == (tg + 1u) * nx) xb_add(&bar[XB_TOPGEN], 1u);
            else XB_SPIN(xb_ld(&bar[XB_TOPGEN]) == tg, bar);
            __builtin_amdgcn_fence(__ATOMIC_ACQUIRE, "agent");
            xb_add(&bar[XB_XGEN(b.x)], 1u);
            asm volatile("s_waitcnt vmcnt(0)" ::: "memory");
        } else {
            XB_SPIN(xb_ld(&bar[XB_XGEN(b.x)]) == gen, bar);
            __builtin_amdgcn_fence(__ATOMIC_ACQUIRE, "agent");
            asm volatile("s_waitcnt vmcnt(0)" ::: "memory");
        }
    }
    __syncthreads();
}


__device__ __forceinline__ void xb2_barrier(unsigned* bar, unsigned x, unsigned nloc, unsigned nx, unsigned k) {
    asm volatile("s_waitcnt vmcnt(0)" ::: "memory");
    __syncthreads();
    if (threadIdx.x == 0) {
        const unsigned old = xb_add(&bar[XB_XSUB(x)], 1u);
        if (old + 1u == (k + 1u) * nloc) {
            __builtin_amdgcn_fence(__ATOMIC_RELEASE, "agent");
            asm volatile("s_waitcnt vmcnt(0)" ::: "memory");
            (void)xb_add(&bar[XB_TOP], 1u);
        }
        while (xb_ld(&bar[XB_TOP]) < (k + 1u) * nx) __builtin_amdgcn_s_sleep(1);
        __builtin_amdgcn_fence(__ATOMIC_ACQUIRE, "agent");
        asm volatile("s_waitcnt vmcnt(0)" ::: "memory");
    }
    __syncthreads();
}
__global__ void __launch_bounds__(512, 2) fwd_megakernel(Params p) {
    extern __shared__ __attribute__((aligned(16))) unsigned char shm[];
    LAS unsigned char* lds = (LAS unsigned char*)shm;
    cg::grid_group grid = cg::this_grid();
    unsigned char* ws = p.ws; const int G = gridDim.x, c = blockIdx.x;
    const size_t TS = (size_t)256 * 1024 * 2;
    bf16_t* slot0 = (bf16_t*)(ws + WS_SLOT);
#define slot(i) ((bf16_t*)(ws + WS_SLOT + (size_t)(i) * SLOT))
    float* O = p.out; bf16_t* O_lo = (bf16_t*)p.out; bf16_t* O_hi = (bf16_t*)((unsigned char*)p.out + SLOT);

    unsigned* const xbar = (unsigned*)(ws + WS_BAR); unsigned* const xtab = xbar + 4096; const unsigned xcc = xb_xcc_id();
    if (blockIdx.x == 0) for (int i = threadIdx.x; i < XCD_BAR_WORDS; i += 512) __hip_atomic_store(&xbar[i], 0u, __ATOMIC_RELAXED, __HIP_MEMORY_SCOPE_AGENT);
    if (threadIdx.x == 0) __hip_atomic_store(&xtab[blockIdx.x], xcc, __ATOMIC_RELAXED, __HIP_MEMORY_SCOPE_AGENT);
    unsigned xb_nloc = 1u, xb_nx = 1u, xb_k = 0u;
#define GSYNC() do { xb2_barrier(xbar, xcc, xb_nloc, xb_nx, xb_k); ++xb_k; } while (0)
#define WGSYNC() do { asm volatile("s_waitcnt vmcnt(0)" ::: "memory"); __syncthreads(); if (threadIdx.x == 0) { __builtin_amdgcn_fence(__ATOMIC_ACQUIRE, "agent"); asm volatile("s_waitcnt vmcnt(0)" ::: "memory"); } __syncthreads(); } while (0)
    {
    phase_prep(p, lds);
    }
    grid.sync();
    { unsigned mine = 0u, present = 0u; const int lane_ = threadIdx.x & 63;
      for (int base = 0; base < (int)gridDim.x; base += 64) { const int e = base + lane_; const unsigned v = (e < (int)gridDim.x) ? xb_ld(&xtab[e]) : 0xffu;
          mine += (unsigned)__builtin_popcountll(__builtin_amdgcn_ballot_w64(v == xcc));
#pragma unroll
          for (unsigned id = 0; id < 16; ++id) present |= (__builtin_amdgcn_ballot_w64(v == id) != 0ull) ? (1u << id) : 0u; }
      xb_nloc = (unsigned)__builtin_amdgcn_readfirstlane((int)mine); xb_nx = (unsigned)__builtin_amdgcn_readfirstlane((int)__builtin_popcount(present)); }
    {
    { SchedProj S; S.o.init(128, 28, G, c); S.xb = (const char*)O_lo; S.win = (const char*)(ws + WS_WIN); S.memb = (const char*)(ws + WS_MEMB); S.wk = (const char*)(ws + WS_WK); S.wv = (const char*)(ws + WS_WV);
      EpiProj E{slot0, p.in[13], (bf16_t*)(ws + WS_KB), (bf16_t*)(ws + WS_VT)};
      gemm_phase(lds, 1024, 1024, 1024, S, E); }
    }
    GSYNC();
    {
    phase_conv(p);
    { SchedKVS S; S.G = G; S.c = c; S.memb = (const char*)(ws + WS_MEMB); S.wk = (const char*)(ws + WS_WK); S.wv = (const char*)(ws + WS_WV);
      EpiPart E{(float*)slot(4)};
      gemm_phase(lds, 1024, 1024, 256, S, E); }
    }
    GSYNC();
    {
    { SchedG S; S.o.init(128, 8, G, c); S.A = (const char*)O_hi; S.B = (const char*)(ws + WS_WG); S.a_pm = TS; S.a_pn = 512; S.a_sh = 1; S.b_pn = (size_t)256 * 256 * 2; S.b_pb = 0;
      EpiGates E{O_hi, p.in[6], p.in[8], (const float*)(ws + WS_SP), (unsigned short*)slot(1), (unsigned short*)slot(2)};
      gemm_phase(lds, 1024, 256, 256, S, E); }
    { const float* part = (const float*)slot(4); bf16_t* kb = (bf16_t*)(ws + WS_KB); bf16_t* vb = (bf16_t*)(ws + WS_VT);
      for (int i = blockIdx.x * 512 + tid_opaque(); i < 2 * 1024 * 128; i += gridDim.x * 512) { const int mat = i >> 17, e8 = (i & 131071) * 8; const float* q = part + (size_t)mat * 4 * 1024 * 1024 + e8;
          f32x4 a = *(const f32x4*)q, b = *(const f32x4*)(q + 4);
#pragma unroll
          for (int ks = 1; ks < 4; ++ks) { a += *(const f32x4*)(q + (size_t)ks * 1024 * 1024); b += *(const f32x4*)(q + (size_t)ks * 1024 * 1024 + 4); }
          float f[8] = {a[0], a[1], a[2], a[3], b[0], b[1], b[2], b[3]}; *(u32x4*)((mat ? vb : kb) + e8) = pack8(f); } }
    }
    GSYNC();
    {
    phase_scan1(p);
    { SchedPre S; S.G = G; S.c = c; S.kb = (const char*)(ws + WS_KB); S.wq = (const char*)(ws + WS_WQ); S.wxo = (const char*)(ws + WS_WXO); S.vb = (const char*)(ws + WS_VT);
      EpiPre E{(bf16_t*)O_hi, (bf16_t*)O_hi + (size_t)16 * 256 * 1024};
      gemm_phase(lds, 1024, 1024, 256, S, E); }
    }
    GSYNC();
    {
    phase_scan3(p);
    }
    GSYNC();
    {
    { SchedMerge S; S.o.init(128, 4, G, c); S.A1 = (const char*)slot(3); S.B1 = (const char*)(ws + WS_WLRU); S.A2 = (const char*)O_lo; S.B2 = (const char*)(ws + WS_WSC);
      EpiMerge E{slot(5), slot(6), slot(4)};
      gemm_phase(lds, 1024, 1024, 1024, S, E); }
    }
    GSYNC();
    {
    { SchedG S; S.o.init(128, 4, G, c); S.A = (const char*)slot(4); S.B = (const char*)(ws + WS_WMIX); S.a_pm = TS; S.a_pn = 0; S.a_sh = 0; S.b_pn = TS; S.b_pb = 0;
      EpiRes E{p.in[0], (unsigned short*)O};
      gemm_phase(lds, 1024, 1024, 1024, S, E); }
    }
    GSYNC();
    {
    phase_ln((const unsigned short*)O, p.in[15], p.in[16], slot(3), nullptr);
    }
    GSYNC();
    {
    { SchedG S; S.o.init(128, 4, G, c); S.A = (const char*)slot(3); S.B = (const char*)O_hi; S.a_pm = TS; S.a_pn = 0; S.a_sh = 0; S.b_pn = TS; S.b_pb = 4 * TS;
      EpiScoreN E{slot(4)};
      gemm_phase(lds, 1024, 1024, 1024, S, E); }
    }
    GSYNC();
    {
    { SchedG S; S.o.init(128, 4, G, c); S.A = (const char*)slot(4); S.B = (const char*)((bf16_t*)O_hi + (size_t)16 * 256 * 1024); S.a_pm = TS; S.a_pn = 0; S.a_sh = 0; S.b_pn = TS; S.b_pb = 4 * TS;
      EpiResB E{slot(3), (unsigned short*)O};
      gemm_phase(lds, 1024, 1024, 1024, S, E); }
    }
    GSYNC();
    {
    phase_ln((const unsigned short*)O, p.in[21], p.in[22], slot(3), nullptr);
    }
    GSYNC();
    {
    { SchedG S; S.o.init(128, 12, G, c); S.A = (const char*)slot(3); S.B = (const char*)(ws + WS_WFG); S.a_pm = TS; S.a_pn = 0; S.a_sh = 0; S.b_pn = TS; S.b_pb = 0;
      EpiBf16 E{slot(4), DFF, 1.0f};
      gemm_phase(lds, 1024, 1024, 1024, S, E); }
    }
    GSYNC();
    {
    { SchedG S; S.o.init(128, 12, G, c); S.A = (const char*)slot(3); S.B = (const char*)(ws + WS_WFU); S.a_pm = TS; S.a_pn = 0; S.a_sh = 0; S.b_pn = TS; S.b_pb = 0;
      EpiFfnUp E{slot(4), p.in[25], p.in[26], slot(0)};
      gemm_phase(lds, 1024, 1024, 1024, S, E); }
    }
    GSYNC();
    {
    { SchedG S; S.o.init(128, 4, G, c); S.A = (const char*)slot(0); S.B = (const char*)(ws + WS_WFD); S.a_pm = (size_t)256 * DFF * 2; S.a_pn = 0; S.a_sh = 0; S.b_pn = (size_t)256 * DFF * 2; S.b_pb = 0;
      EpiResB E{slot(3), (unsigned short*)slot(4)};
      gemm_phase(lds, DFF, DFF, DFF, S, E); }
    }
    GSYNC();
    {
    phase_ln((const unsigned short*)slot(4), p.in[28], p.in[29], nullptr, O);
    }
}

extern "C" void kernel_launch(void* const* d_in, const int* in_sizes, int n_in, void* d_out, int out_size, void* d_ws, size_t ws_size, hipStream_t stream) {
    static int grid_blocks = 0;
    if (grid_blocks == 0) {
        if (n_in != 30 || out_size != MT * DM || ws_size < WS_END) { fprintf(stderr, "kernel_launch: unexpected shapes (n_in %d out %d ws %zu, need %zu)\n", n_in, out_size, ws_size, (size_t)WS_END); grid_blocks = -1; return; }
        int dev = 0, cus = 0, per_cu = 0;
        (void)hipGetDevice(&dev);
        (void)hipDeviceGetAttribute(&cus, hipDeviceAttributeMultiprocessorCount, dev);
        if (hipFuncSetAttribute((const void*)fwd_megakernel, hipFuncAttributeMaxDynamicSharedMemorySize, LDS_BYTES) != hipSuccess) { fprintf(stderr, "kernel_launch: hipFuncSetAttribute failed\n"); grid_blocks = -1; return; }
        if (hipOccupancyMaxActiveBlocksPerMultiprocessor(&per_cu, (const void*)fwd_megakernel, 512, LDS_BYTES) != hipSuccess || per_cu < 1) { fprintf(stderr, "kernel_launch: occupancy query failed (%d)\n", per_cu); grid_blocks = -1; return; }
        grid_blocks = cus * 1;
    }
    if (grid_blocks < 0) return;
    Params p{};
    for (int i = 0; i < 30; ++i) p.in[i] = (const float*)d_in[i];
    p.out = (float*)d_out; p.ws = (unsigned char*)d_ws;
    void* args[] = {&p};
    hipError_t e = hipLaunchCooperativeKernel((const void*)fwd_megakernel, dim3(grid_blocks), dim3(512), args, LDS_BYTES, stream);
    if (e != hipSuccess) fprintf(stderr, "cooperative launch failed: %s (grid %d)\n", hipGetErrorString(e), grid_blocks);
}
```
